# Optimizing an MI355X kernel written in HIP

```python
import math
import jax, jax.numpy as jnp
from jax import lax
import numpy as np

D_MODEL = 1024
BATCH = 8
SEQ = 4096
DEPTH = 4

GRID_W = 64
Q_BLOCK = 128
ROPE_THETA = 500000.0
AXIAL_THETA = 10000.0
LN_EPS = 1e-5
RMS_EPS = 1e-6

A_HEADS = 4
A_QK_DIM = 64
A_V_DIM = 2 * A_QK_DIM
A_WIDTH = A_HEADS * A_V_DIM
A_ROT = A_QK_DIM // 4

B_Q_HEADS = 8
B_KV_HEADS = 2
B_GROUP = B_Q_HEADS // B_KV_HEADS
B_DIM = 64
B_WIDTH = B_Q_HEADS * B_DIM

EVEN_WIDTH = A_WIDTH + B_WIDTH
EV_SPLITS = [
    A_HEADS * 2 * A_QK_DIM,
    A_HEADS * 2 * A_QK_DIM,
    A_HEADS * A_V_DIM,
    B_Q_HEADS * B_DIM,
    B_KV_HEADS * B_DIM,
    B_KV_HEADS * B_DIM,
    EVEN_WIDTH,
]
EV_IN = sum(EV_SPLITS)

C_HEADS = 16
C_NOPE = 64
C_ROPE = 32
C_V = 64
C_Q_LORA = 256
C_KV_LORA = 128
C_WIDTH = C_HEADS * C_V
OD_SPLITS = [C_Q_LORA, C_KV_LORA, C_ROPE, C_WIDTH]
OD_IN = sum(OD_SPLITS)

N_EVEN = (DEPTH + 1) // 2
N_ODD = DEPTH // 2
ALPHA = (2 * DEPTH) ** 0.25
BETA = (8 * DEPTH) ** -0.25

kernel_name = "hybrid_diffattn_gqa_mla_deepnorm_encoder"


def _split_points(sizes):
    return [int(v) for v in np.cumsum(sizes)[:-1]]


def _rms(x, g):
    xf = x.astype(jnp.float32)
    y = xf * lax.rsqrt(jnp.mean(xf * xf, axis=-1, keepdims=True) + RMS_EPS)
    return (y * g.astype(jnp.float32)).astype(x.dtype)


def _layernorm(x, g, b):
    xf = x.astype(jnp.float32)
    mu = jnp.mean(xf, axis=-1, keepdims=True)
    var = jnp.mean(jnp.square(xf - mu), axis=-1, keepdims=True)
    y = (xf - mu) * lax.rsqrt(var + LN_EPS)
    return (y * g.astype(jnp.float32) + b.astype(jnp.float32)).astype(x.dtype)


def _rope_angles(pos, dims, theta):
    inv = theta ** (-jnp.arange(0, dims, 2, dtype=jnp.float32) / dims)
    ang = pos.astype(jnp.float32)[:, None] * inv[None, :]
    return jnp.cos(ang), jnp.sin(ang)


def _rotate(x, cos, sin):
    xf = x.astype(jnp.float32)
    x1, x2 = jnp.split(xf, 2, axis=-1)
    out = jnp.concatenate([x1 * cos - x2 * sin, x2 * cos + x1 * sin], axis=-1)
    return out.astype(x.dtype)


def _partial_rope(x, cos, sin, rot):
    return jnp.concatenate([_rotate(x[..., :rot], cos, sin), x[..., rot:]], axis=-1)


def _axial_rope(x, row_cs, col_cs):
    half = x.shape[-1] // 2
    return jnp.concatenate([_rotate(x[..., :half], *row_cs),
                            _rotate(x[..., half:], *col_cs)], axis=-1)


def _to_blocks(q):
    *lead, s, d = q.shape
    qb = q.reshape(*lead, s // Q_BLOCK, Q_BLOCK, d)
    return jnp.moveaxis(qb, -3, 0)


def _from_blocks(o):
    o = jnp.moveaxis(o, 0, -3)
    *lead, nb, blk, d = o.shape
    return o.reshape(*lead, nb * blk, d)


def _grouped_attention(q, k, v, scale):
    def one(qb):
        s = jnp.einsum('bgrqd,bgkd->bgrqk', qb, k,
                       preferred_element_type=jnp.float32) * scale
        p = jax.nn.softmax(s, axis=-1)
        return jnp.einsum('bgrqk,bgkd->bgrqd', p.astype(v.dtype), v)
    return _from_blocks(lax.map(one, _to_blocks(q)))


def _diff_attention(q, k, v, lam, scale):
    def one(qb):
        s = jnp.einsum('bhcqd,bhckd->bhcqk', qb, k,
                       preferred_element_type=jnp.float32) * scale
        p = jax.nn.softmax(s, axis=-1)
        pd = p[:, :, 0] - lam * p[:, :, 1]
        return jnp.einsum('bhqk,bhkd->bhqd', pd.astype(v.dtype), v)
    return _from_blocks(lax.map(one, _to_blocks(q)))


def _even_layer(x, w_in, w_out, lam_p, subln_g, qn_g, kn_g, ln_g, ln_b,
                layer_idx, rope_a, row_cs, col_cs):
    bsz, s, _ = x.shape
    h = jnp.einsum('bsd,de->bse', x, w_in)
    qa, ka, va, qb, kb, vb, gate = jnp.split(h, _split_points(EV_SPLITS), axis=-1)

    qa = qa.reshape(bsz, s, A_HEADS, 2, A_QK_DIM).transpose(0, 2, 3, 1, 4)
    ka = ka.reshape(bsz, s, A_HEADS, 2, A_QK_DIM).transpose(0, 2, 3, 1, 4)
    va = va.reshape(bsz, s, A_HEADS, A_V_DIM).transpose(0, 2, 1, 3)
    qa = _partial_rope(qa, *rope_a, A_ROT)
    ka = _partial_rope(ka, *rope_a, A_ROT)
    lam_init = 0.8 - 0.6 * math.exp(-0.3 * layer_idx)
    lp = lam_p.astype(jnp.float32)
    lam = (jnp.exp(jnp.sum(lp[0] * lp[1])) - jnp.exp(jnp.sum(lp[2] * lp[3]))
           + lam_init)
    oa = _diff_attention(qa, ka, va, lam, A_QK_DIM ** -0.5)
    oa = _rms(oa, subln_g) * (1.0 - lam_init)
    oa = oa.transpose(0, 2, 1, 3).reshape(bsz, s, A_WIDTH)

    qb = _rms(qb.reshape(bsz, s, B_Q_HEADS, B_DIM), qn_g).transpose(0, 2, 1, 3)
    kb = _rms(kb.reshape(bsz, s, B_KV_HEADS, B_DIM), kn_g).transpose(0, 2, 1, 3)
    vb = vb.reshape(bsz, s, B_KV_HEADS, B_DIM).transpose(0, 2, 1, 3)
    qb = _axial_rope(qb, row_cs, col_cs).reshape(bsz, B_KV_HEADS, B_GROUP, s, B_DIM)
    kb = _axial_rope(kb, row_cs, col_cs)
    ob = _grouped_attention(qb, kb, vb, B_DIM ** -0.5)
    ob = ob.transpose(0, 3, 1, 2, 4).reshape(bsz, s, B_WIDTH)

    o = jnp.concatenate([oa, ob], axis=-1) * jax.nn.silu(gate)
    y = jnp.einsum('bse,ed->bsd', o, w_out)
    return _layernorm(ALPHA * x + y, ln_g, ln_b)


def _odd_layer(x, w_in, q_norm, kv_norm, w_qb, w_kvb, w_out, ln_g, ln_b, rope_c):
    bsz, s, _ = x.shape
    h = jnp.einsum('bsd,de->bse', x, w_in)
    cq, ckv, kr, gate = jnp.split(h, _split_points(OD_SPLITS), axis=-1)

    cq = _rms(cq, q_norm)
    q = jnp.einsum('bsc,ce->bse', cq, w_qb).reshape(bsz, s, C_HEADS, C_NOPE + C_ROPE)
    q = q.transpose(0, 2, 1, 3)
    q = jnp.concatenate([q[..., :C_NOPE], _rotate(q[..., C_NOPE:], *rope_c)], axis=-1)

    ckv = _rms(ckv, kv_norm)
    kv = jnp.einsum('bsc,ce->bse', ckv, w_kvb).reshape(bsz, s, C_HEADS, C_NOPE + C_V)
    kv = kv.transpose(0, 2, 1, 3)
    k_nope, v = kv[..., :C_NOPE], kv[..., C_NOPE:]
    kr = _rotate(kr[:, None], *rope_c)
    kr = jnp.broadcast_to(kr, (bsz, C_HEADS, s, C_ROPE))
    k = jnp.concatenate([k_nope, kr], axis=-1)

    o = _grouped_attention(q[:, :, None], k, v, (C_NOPE + C_ROPE) ** -0.5)[:, :, 0]
    o = o.transpose(0, 2, 1, 3).reshape(bsz, s, C_WIDTH) * jax.nn.silu(gate)
    y = jnp.einsum('bse,ed->bsd', o, w_out)
    return _layernorm(ALPHA * x + y, ln_g, ln_b)


def setup_inputs(seed: int = 0) -> dict:
    key = jax.random.key(seed)
    ks = jax.random.split(key, 20)

    def nrm(k, shape, scale):
        return jax.random.normal(k, shape, jnp.float32) * scale

    return {
        "x": nrm(ks[0], (BATCH, SEQ, D_MODEL), 1.0),
        "ev_w_in": nrm(ks[1], (N_EVEN, D_MODEL, EV_IN), D_MODEL ** -0.5),
        "ev_w_out": nrm(ks[2], (N_EVEN, EVEN_WIDTH, D_MODEL), BETA * EVEN_WIDTH ** -0.5),
        "ev_lam": nrm(ks[3], (N_EVEN, 4, A_QK_DIM), 0.1),
        "ev_subln": 1.0 + nrm(ks[4], (N_EVEN, A_V_DIM), 0.02),
        "ev_qnorm": 1.0 + nrm(ks[5], (N_EVEN, B_DIM), 0.02),
        "ev_knorm": 1.0 + nrm(ks[6], (N_EVEN, B_DIM), 0.02),
        "ev_ln_g": 1.0 + nrm(ks[7], (N_EVEN, D_MODEL), 0.02),
        "ev_ln_b": nrm(ks[8], (N_EVEN, D_MODEL), 0.02),
        "od_w_in": nrm(ks[9], (N_ODD, D_MODEL, OD_IN), D_MODEL ** -0.5),
        "od_qnorm": 1.0 + nrm(ks[10], (N_ODD, C_Q_LORA), 0.02),
        "od_kvnorm": 1.0 + nrm(ks[11], (N_ODD, C_KV_LORA), 0.02),
        "od_w_qb": nrm(ks[12], (N_ODD, C_Q_LORA, C_HEADS * (C_NOPE + C_ROPE)), C_Q_LORA ** -0.5),
        "od_w_kvb": nrm(ks[13], (N_ODD, C_KV_LORA, C_HEADS * (C_NOPE + C_V)), C_KV_LORA ** -0.5),
        "od_w_out": nrm(ks[14], (N_ODD, C_WIDTH, D_MODEL), BETA * C_WIDTH ** -0.5),
        "od_ln_g": 1.0 + nrm(ks[15], (N_ODD, D_MODEL), 0.02),
        "od_ln_b": nrm(ks[16], (N_ODD, D_MODEL), 0.02),
    }


def reference(x, ev_w_in, ev_w_out, ev_lam, ev_subln, ev_qnorm, ev_knorm,
              ev_ln_g, ev_ln_b, od_w_in, od_qnorm, od_kvnorm, od_w_qb, od_w_kvb,
              od_w_out, od_ln_g, od_ln_b):
    s = x.shape[1]
    rows = s // GRID_W
    pos = jnp.arange(s, dtype=jnp.int32)
    row = jnp.repeat(jnp.arange(rows, dtype=jnp.int32), GRID_W)
    col = jnp.tile(jnp.arange(GRID_W, dtype=jnp.int32), rows)

    rope_a = _rope_angles(pos, A_ROT, ROPE_THETA)
    rope_c = _rope_angles(pos, C_ROPE, ROPE_THETA)
    row_cs = _rope_angles(row, B_DIM // 2, AXIAL_THETA)
    col_cs = _rope_angles(col, B_DIM // 2, AXIAL_THETA)

    for layer in range(DEPTH):
        i = layer // 2
        if layer % 2 == 0:
            x = _even_layer(x, ev_w_in[i], ev_w_out[i], ev_lam[i], ev_subln[i],
                            ev_qnorm[i], ev_knorm[i], ev_ln_g[i], ev_ln_b[i],
                            layer, rope_a, row_cs, col_cs)
        else:
            x = _odd_layer(x, od_w_in[i], od_qnorm[i], od_kvnorm[i], od_w_qb[i],
                           od_w_kvb[i], od_w_out[i], od_ln_g[i], od_ln_b[i], rope_c)
    return x
```

```cpp
#include <hip/hip_runtime.h>
#include <hip/hip_cooperative_groups.h>
#include <cstdio>
#include <cstdint>
namespace cg = cooperative_groups;
__device__ __forceinline__ int launder_i(int v) { asm volatile("" : "+v"(v)); return v; }
namespace pg8 {
#define PG8_LAS __attribute__((address_space(3)))
typedef unsigned short bf16_t;
typedef short bf16x8 __attribute__((ext_vector_type(8)));
typedef float f32x4 __attribute__((ext_vector_type(4)));
typedef unsigned u32x4 __attribute__((ext_vector_type(4)));
constexpr int BM = 256, BK = 64, HALF = 128, HTB = HALF * BK * 2  , STAGE_BYTES = 8 * HTB, NXCD = 8, WGM = 8;

__host__ __device__ __forceinline__ int lds_byte(int r, int c) { const int st = (r >> 4) * 2 + (c >> 5), rr = r & 15, cc = c & 31, ob = rr * 64 + cc * 2; return st * 1024 + (ob ^ (((ob >> 9) & 1) << 5)); }
__host__ __device__ __forceinline__ void stage_rc(int b, int& R, int& C) { const int st = b / 1024, sb = b % 1024, swz = sb ^ (((sb >> 9) & 1) << 5); R = (st >> 1) * 16 + swz / 64; C = (st & 1) * 32 + (swz % 64) / 2; }
__host__ __device__ __forceinline__ int perm32(int rho) { const int n = rho >> 4, i = rho & 15; return 8 * (i >> 2) + 4 * n + (i & 3); }

struct Unit { int pm, pn; };
struct Gemm { const bf16_t* A; const bf16_t* Bt; int M, N, K; };

struct StaticOrder {
    int nM, nN, nwg, G, c;
    __host__ __device__ void init(int M, int N, int G_, int c_) { nM = M / BM; nN = N / BM; nwg = nM * nN; G = G_; c = c_; }
    __host__ __device__ bool next(int i, Unit& u) const {
        const long L = (long)i * G + c; if (L >= nwg) return false;
        int wgid = (int)L; { const int q = nwg / NXCD, r = nwg % NXCD, xcd = wgid % NXCD, off = wgid / NXCD; wgid = (xcd < r ? xcd * (q + 1) : r * (q + 1) + (xcd - r) * q) + off; }
        const int nig = WGM * nN, gid = wgid / nig, fm = gid * WGM, gsz = (nM - fm) < WGM ? (nM - fm) : WGM;
        u.pm = fm + ((wgid % nig) % gsz); u.pn = (wgid % nig) / gsz; return true;
    }
    __device__ __forceinline__ void a_ready(const Unit&) const {}
    __device__ __forceinline__ void done(const Unit&) const {}
};

__device__ __forceinline__ unsigned cvt_pk_bf16(float lo, float hi) { unsigned r; asm volatile("v_cvt_pk_bf16_f32 %0, %1, %2" : "=v"(r) : "v"(lo), "v"(hi)); return r; }
__device__ __forceinline__ float silu_f(float v) { return v * __builtin_amdgcn_rcpf(1.0f + __builtin_amdgcn_exp2f(-1.4426950408889634f * v)); }
__device__ __forceinline__ f32x4 silu4(f32x4 v) { return (f32x4){silu_f(v[0]), silu_f(v[1]), silu_f(v[2]), silu_f(v[3])}; }

struct EpiBf16S {
    static constexpr bool PERM = true, AFTER_DRAIN = false;
    bf16_t* O; int ldc; int silu_from; float scale; int scale_until;
    __device__ __forceinline__ void operator()(const f32x4 (&acc)[2][2][4][2], const Unit& u, int wr, int wc, int fr, int fq) const {
        const int row0 = u.pm * BM + wr * 64 + fr; const int colt = u.pn * BM;
        const bool act = colt >= silu_from; const float sc = colt < scale_until ? scale : 1.f;
        const int col0 = colt + wc * 32 + 8 * fq;
#pragma unroll
        for (int ai = 0; ai < 2; ++ai)
#pragma unroll
            for (int m = 0; m < 4; ++m) { bf16_t* rowp = O + (size_t)(row0 + ai * HALF + m * 16) * ldc + col0;
#pragma unroll
                for (int bj = 0; bj < 2; ++bj) { f32x4 v0 = acc[ai][bj][m][0], v1 = acc[ai][bj][m][1];
                    if (act) { v0 = silu4(v0); v1 = silu4(v1); }
                    v0 = v0 * sc; v1 = v1 * sc; u32x4 w; w.x = cvt_pk_bf16(v0[0], v0[1]); w.y = cvt_pk_bf16(v0[2], v0[3]); w.z = cvt_pk_bf16(v1[0], v1[1]); w.w = cvt_pk_bf16(v1[2], v1[3]);
                    *(u32x4*)(rowp + bj * HALF) = w; } }
    }
};
struct EpiOddIn {
    static constexpr bool PERM = true, AFTER_DRAIN = false;
    float* HF; bf16_t* G;
    __device__ __forceinline__ void operator()(const f32x4 (&acc)[2][2][4][2], const Unit& u, int wr, int wc, int fr, int fq) const {
        const int row0 = u.pm * BM + wr * 64 + fr; const int colt = u.pn * BM;
        const int col0 = colt + wc * 32 + 8 * fq;
        if (colt < 512) {
#pragma unroll
            for (int ai = 0; ai < 2; ++ai)
#pragma unroll
                for (int m = 0; m < 4; ++m) { float* rowp = HF + (size_t)(row0 + ai * HALF + m * 16) * 512 + col0;
#pragma unroll
                    for (int bj = 0; bj < 2; ++bj) { *(f32x4*)(rowp + bj * HALF) = acc[ai][bj][m][0]; *(f32x4*)(rowp + bj * HALF + 4) = acc[ai][bj][m][1]; } }
        } else {
#pragma unroll
            for (int ai = 0; ai < 2; ++ai)
#pragma unroll
                for (int m = 0; m < 4; ++m) { bf16_t* rowp = G + (size_t)(row0 + ai * HALF + m * 16) * 1024 + (col0 - 512);
#pragma unroll
                    for (int bj = 0; bj < 2; ++bj) { const f32x4 v0 = silu4(acc[ai][bj][m][0]), v1 = silu4(acc[ai][bj][m][1]);
                        u32x4 w; w.x = cvt_pk_bf16(v0[0], v0[1]); w.y = cvt_pk_bf16(v0[2], v0[3]); w.z = cvt_pk_bf16(v1[0], v1[1]); w.w = cvt_pk_bf16(v1[2], v1[3]);
                        *(u32x4*)(rowp + bj * HALF) = w; } }
        }
    }
};
struct EpiF32 {
    static constexpr bool PERM = false, AFTER_DRAIN = false;
    float* Y; int ldc;
    __device__ __forceinline__ void operator()(const f32x4 (&acc)[2][2][4][2], const Unit& u, int wr, int wc, int fr, int fq) const {
        const int row0 = u.pm * BM + wr * 64 + fr; const int col0 = u.pn * BM + wc * 32 + 4 * fq;
#pragma unroll
        for (int ai = 0; ai < 2; ++ai)
#pragma unroll
            for (int m = 0; m < 4; ++m) { float* rowp = Y + (size_t)(row0 + ai * HALF + m * 16) * ldc + col0;
#pragma unroll
                for (int bj = 0; bj < 2; ++bj)
#pragma unroll
                    for (int n = 0; n < 2; ++n) *(f32x4*)(rowp + bj * HALF + n * 16) = acc[ai][bj][m][n]; }
    }
};

template <class Epi, class Sched, bool ALIGN_EPI = false, bool SP2 = false>
__device__ __forceinline__ void gemm_phase(PG8_LAS unsigned char* lds, const Gemm g, const Sched& S, const Epi& E) {
    const int tid = launder_i(threadIdx.x), wid = __builtin_amdgcn_readfirstlane(tid >> 6), lane = tid & 63, wr = wid >> 2, wc = wid & 3, fr = lane & 15, fq = lane >> 4;
    const int K = g.K, nt = K / BK;
    unsigned voffA[2], voffB[2];
#pragma unroll
    for (int i = 0; i < 2; ++i) { int R, C; stage_rc(tid * 16 + i * 8192, R, C); const int Rb = Epi::PERM ? ((R & ~31) + perm32(R & 31)) : R;
        voffA[i] = (unsigned)(R * K + C) * 2u; voffB[i] = (unsigned)(Rb * K + C) * 2u; }
    const size_t kstep = (size_t)(BK * 2);
    const size_t hstep = (size_t)HALF * K * 2;
    const size_t tstep = 2 * hstep;
    const unsigned ldsw = (unsigned)wid * 1024u;
    const int aoff = lds_byte(wr * 64 + fr, fq * 8), boff = lds_byte(wc * 32 + fr, fq * 8);
#define PG8_SA(b, h) (((b) * 2 + (h)) * HTB)
#define PG8_SB(b, h) ((4 + (b) * 2 + (h)) * HTB)
#define PG8_STAGE(bufoff, gbase, voff) do { _Pragma("unroll") for (int _i = 0; _i < 2; ++_i) \
        __builtin_amdgcn_global_load_lds((const unsigned*)((const char*)(gbase) + (voff)[_i]), (PG8_LAS unsigned*)(lds + (bufoff) + ldsw + _i * 8192), 16, 0, 0); } while (0)
#define PG8_LDA(dst, b, h) do { _Pragma("unroll") for (int m = 0; m < 4; ++m) _Pragma("unroll") for (int k = 0; k < 2; ++k) dst[m][k] = *(const PG8_LAS bf16x8*)(lds + PG8_SA(b, h) + aoff + m * 2048 + k * 1024); } while (0)
#define PG8_LDB(dst, b, h) do { _Pragma("unroll") for (int n = 0; n < 2; ++n) _Pragma("unroll") for (int k = 0; k < 2; ++k) dst[n][k] = *(const PG8_LAS bf16x8*)(lds + PG8_SB(b, h) + boff + n * 2048 + k * 1024); } while (0)
#define PG8_MMA(ai, bj, At, Bt) do { __builtin_amdgcn_s_setprio(1); _Pragma("unroll") for (int m = 0; m < 4; ++m) _Pragma("unroll") for (int n = 0; n < 2; ++n) _Pragma("unroll") for (int k = 0; k < 2; ++k) \
        acc[ai][bj][m][n] = __builtin_amdgcn_mfma_f32_16x16x32_bf16(Bt[n][k], At[m][k], acc[ai][bj][m][n], 0, 0, 0); __builtin_amdgcn_s_setprio(0); } while (0)
#define PG8_WAIT_V(n) asm volatile("s_waitcnt vmcnt(" #n ")" ::: "memory")
#define PG8_WAIT_L(n) asm volatile("s_waitcnt lgkmcnt(" #n ")" ::: "memory")
#define PG8_BAR __builtin_amdgcn_s_barrier()
#define PG8_SCHED __builtin_amdgcn_sched_barrier(0)
    Unit cur, nxt; int ui = 0;
    if (!S.next(0, cur)) return;
    f32x4 acc[2][2][4][2];
#pragma unroll
    for (int a = 0; a < 2; ++a)
#pragma unroll
        for (int b = 0; b < 2; ++b)
#pragma unroll
            for (int m = 0; m < 4; ++m)
#pragma unroll
                for (int n = 0; n < 2; ++n) acc[a][b][m][n] = (f32x4){0.f, 0.f, 0.f, 0.f};
    bf16x8 At[4][2], B0[2][2], B1[2][2];
    const char* cA = (const char*)g.A + (size_t)cur.pm * tstep; const char* cB = (const char*)g.Bt + (size_t)cur.pn * tstep;
    S.a_ready(cur);
    if constexpr (SP2) {
        PG8_STAGE(PG8_SB(0, 0), cB, voffB); PG8_STAGE(PG8_SB(0, 1), cB + hstep, voffB); PG8_STAGE(PG8_SA(0, 0), cA, voffA); PG8_STAGE(PG8_SA(0, 1), cA + hstep, voffA);
        if (wr == 1) PG8_BAR;
        PG8_WAIT_V(2); PG8_BAR;
        PG8_STAGE(PG8_SB(1, 0), cB + kstep, voffB); PG8_STAGE(PG8_SA(1, 0), cA + kstep, voffA); PG8_STAGE(PG8_SB(1, 1), cB + hstep + kstep, voffB);
        PG8_WAIT_V(6); PG8_BAR;
    } else {
        PG8_STAGE(PG8_SB(0, 0), cB, voffB); PG8_STAGE(PG8_SA(0, 0), cA, voffA); PG8_STAGE(PG8_SB(0, 1), cB + hstep, voffB); PG8_STAGE(PG8_SA(0, 1), cA + hstep, voffA);
        if (wr == 1) PG8_BAR;
        PG8_WAIT_V(4); PG8_BAR;
        PG8_STAGE(PG8_SB(1, 0), cB + kstep, voffB); PG8_STAGE(PG8_SA(1, 0), cA + kstep, voffA); PG8_STAGE(PG8_SB(1, 1), cB + hstep + kstep, voffB);
        PG8_WAIT_V(6); PG8_BAR;
    }
    for (;;) {
        const bool has_next = S.next(ui + 1, nxt);
        const char* nA = has_next ? (const char*)g.A + (size_t)nxt.pm * tstep : cA; const char* nB = has_next ? (const char*)g.Bt + (size_t)nxt.pn * tstep : cB;
        for (int t = 0; t < nt; t += 2) {
            const bool last = (t == nt - 2);
            const char* a1 = cA + (size_t)(t + 1) * kstep;
            const char* a2 = last ? nA : cA + (size_t)(t + 2) * kstep; const char* b2 = last ? nB : cB + (size_t)(t + 2) * kstep;
            const char* a3 = a2 + kstep; const char* b3 = b2 + kstep;
            if (last && has_next) S.a_ready(nxt);
            if constexpr (SP2) {
            PG8_LDB(B0, 0, 0); PG8_LDB(B1, 0, 1); PG8_SCHED; PG8_LDA(At, 0, 0); PG8_STAGE(PG8_SA(1, 1), a1 + hstep, voffA);
            PG8_WAIT_V(8); PG8_WAIT_L(0); PG8_BAR; PG8_MMA(0, 0, At, B0); PG8_MMA(0, 1, At, B1); PG8_BAR; PG8_SCHED;
            PG8_LDA(At, 0, 1); PG8_STAGE(PG8_SB(0, 0), b2, voffB); PG8_STAGE(PG8_SB(0, 1), b2 + hstep, voffB); PG8_STAGE(PG8_SA(0, 0), a2, voffA);
            PG8_WAIT_V(8); PG8_WAIT_L(0); PG8_BAR; PG8_MMA(1, 0, At, B0); PG8_MMA(1, 1, At, B1); PG8_BAR; PG8_SCHED;
            PG8_LDB(B0, 1, 0); PG8_LDB(B1, 1, 1); PG8_SCHED; PG8_LDA(At, 1, 0); PG8_STAGE(PG8_SA(0, 1), a2 + hstep, voffA);
            PG8_WAIT_V(8); PG8_WAIT_L(0); PG8_BAR; PG8_MMA(0, 0, At, B0); PG8_MMA(0, 1, At, B1); PG8_BAR; PG8_SCHED;
            PG8_LDA(At, 1, 1); PG8_STAGE(PG8_SB(1, 0), b3, voffB); PG8_STAGE(PG8_SB(1, 1), b3 + hstep, voffB); PG8_STAGE(PG8_SA(1, 0), a3, voffA);
            PG8_WAIT_V(8); PG8_WAIT_L(0); PG8_BAR; PG8_MMA(1, 0, At, B0); PG8_MMA(1, 1, At, B1); PG8_BAR; PG8_SCHED;
            } else {
            PG8_LDB(B0, 0, 0); PG8_SCHED; PG8_LDA(At, 0, 0); PG8_STAGE(PG8_SA(1, 1), a1 + hstep, voffA);
            PG8_WAIT_L(8); PG8_BAR; PG8_WAIT_L(0); PG8_MMA(0, 0, At, B0); PG8_BAR; PG8_SCHED;
            PG8_LDB(B1, 0, 1); PG8_STAGE(PG8_SB(0, 0), b2, voffB);
            PG8_BAR; PG8_WAIT_L(0); PG8_MMA(0, 1, At, B1); PG8_BAR;
            PG8_LDA(At, 0, 1); PG8_STAGE(PG8_SA(0, 0), a2, voffA);
            PG8_BAR; PG8_WAIT_L(0); PG8_MMA(1, 0, At, B0); PG8_BAR; PG8_SCHED;
            PG8_STAGE(PG8_SB(0, 1), b2 + hstep, voffB);
            PG8_WAIT_V(6); PG8_BAR; PG8_MMA(1, 1, At, B1); PG8_BAR;
            PG8_LDB(B0, 1, 0); PG8_SCHED; PG8_LDA(At, 1, 0); PG8_STAGE(PG8_SA(0, 1), a2 + hstep, voffA);
            PG8_WAIT_L(8); PG8_BAR; PG8_WAIT_L(0); PG8_MMA(0, 0, At, B0); PG8_BAR; PG8_SCHED;
            PG8_LDB(B1, 1, 1); PG8_STAGE(PG8_SB(1, 0), b3, voffB);
            PG8_BAR; PG8_WAIT_L(0); PG8_MMA(0, 1, At, B1); PG8_BAR;
            PG8_LDA(At, 1, 1); PG8_STAGE(PG8_SA(1, 0), a3, voffA);
            PG8_BAR; PG8_WAIT_L(0); PG8_MMA(1, 0, At, B0); PG8_BAR; PG8_SCHED;
            PG8_STAGE(PG8_SB(1, 1), b3 + hstep, voffB);
            PG8_WAIT_V(6); PG8_BAR; PG8_MMA(1, 1, At, B1); PG8_BAR;
            }
        }
        if constexpr (ALIGN_EPI) { if (wr == 0) PG8_BAR; }
        if constexpr (!Epi::AFTER_DRAIN) { E(acc, cur, wr, wc, fr, fq); S.done(cur); }
        if (!has_next) break;
#pragma unroll
        for (int a = 0; a < 2; ++a)
#pragma unroll
            for (int b = 0; b < 2; ++b)
#pragma unroll
                for (int m = 0; m < 4; ++m)
#pragma unroll
                    for (int n = 0; n < 2; ++n) acc[a][b][m][n] = (f32x4){0.f, 0.f, 0.f, 0.f};
        cur = nxt; cA = nA; cB = nB; ++ui;
        if constexpr (ALIGN_EPI) { if (wr == 1) PG8_BAR; }
    }
    PG8_WAIT_V(0);
    if constexpr (!ALIGN_EPI) { if (wr == 0) PG8_BAR; }
    PG8_BAR;
    if constexpr (Epi::AFTER_DRAIN) { E.fused(acc, cur, wr, wc, fr, fq, lds, wid, lane); S.done(cur); }
#undef PG8_SA
#undef PG8_SB
#undef PG8_STAGE
#undef PG8_LDA
#undef PG8_LDB
#undef PG8_MMA
#undef PG8_WAIT_V
#undef PG8_WAIT_L
#undef PG8_BAR
#undef PG8_SCHED
}
}

namespace att {
typedef unsigned short bf16_t;
using bf16x8 = __attribute__((ext_vector_type(8))) short;
using s16x4  = __attribute__((ext_vector_type(4))) short;
using f32x16 = __attribute__((ext_vector_type(16))) float;
using u32x4  = __attribute__((ext_vector_type(4))) unsigned;
#define SBAR() __builtin_amdgcn_sched_barrier(0)
constexpr float THR = 8.f;
__device__ __forceinline__ int crow(int r, int hi) { return (r & 3) + 8 * (r >> 2) + 4 * hi; }
__device__ __forceinline__ unsigned cvtpk(float lo, float hi) { unsigned r; asm volatile("v_cvt_pk_bf16_f32 %0, %1, %2" : "=v"(r) : "v"(lo), "v"(hi)); return r; }
__device__ __forceinline__ float bf2f(bf16_t h) { return __uint_as_float(((unsigned)h) << 16); }
__device__ __forceinline__ bf16_t f2bf(float f) { return (bf16_t)(cvtpk(f, 0.f) & 0xffffu); }

__device__ __forceinline__ void partialSM(f32x16& p0, f32x16& p1, float& m_reg, float& mn, float& alpha) {
  float pmax = p0[0];
#pragma unroll
  for (int r = 1; r < 16; ++r) pmax = fmaxf(pmax, p0[r]);
#pragma unroll
  for (int r = 0; r < 16; ++r) pmax = fmaxf(pmax, p1[r]);
  { auto rr = __builtin_amdgcn_permlane32_swap(__float_as_uint(pmax), __float_as_uint(pmax), false, false);
    pmax = fmaxf(__uint_as_float(rr[0]), __uint_as_float(rr[1])); }
  if (__builtin_expect(__all(pmax - m_reg <= THR), 1)) { mn = m_reg; alpha = 1.f; }
  else { mn = fmaxf(m_reg, pmax); alpha = __builtin_amdgcn_exp2f(m_reg - mn); m_reg = mn; }
#pragma unroll
  for (int r = 0; r < 16; ++r) p0[r] = p0[r] - mn;
#pragma unroll
  for (int r = 0; r < 16; ++r) p1[r] = p1[r] - mn;
#pragma unroll
  for (int r = 0; r < 16; ++r) p0[r] = __builtin_amdgcn_exp2f(p0[r]);
}
__device__ __forceinline__ void finishSM(f32x16& p0, f32x16& p1, float alpha, float& l_reg, bf16x8& pa0, bf16x8& pa1, bf16x8& pa2, bf16x8& pa3) {
#pragma unroll
  for (int r = 0; r < 16; ++r) p1[r] = __builtin_amdgcn_exp2f(p1[r]);
  float ps = 0;
#pragma unroll
  for (int r = 0; r < 16; ++r) ps += p0[r];
#pragma unroll
  for (int r = 0; r < 16; ++r) ps += p1[r];
  { auto rr = __builtin_amdgcn_permlane32_swap(__float_as_uint(ps), __float_as_uint(ps), false, false);
    ps = __uint_as_float(rr[0]) + __uint_as_float(rr[1]); }
  l_reg = l_reg * alpha + ps;
#define PK4(P, BASE, OUT) do { unsigned a0 = cvtpk(P[BASE + 0], P[BASE + 1]), a1 = cvtpk(P[BASE + 2], P[BASE + 3]);   \
    unsigned b0 = cvtpk(P[BASE + 4], P[BASE + 5]), b1 = cvtpk(P[BASE + 6], P[BASE + 7]);                              \
    auto r0 = __builtin_amdgcn_permlane32_swap(a0, b0, false, false); auto r1 = __builtin_amdgcn_permlane32_swap(a1, b1, false, false); \
    u32x4 w = {r0[0], r1[0], r0[1], r1[1]}; OUT = *reinterpret_cast<bf16x8*>(&w); } while (0)
  PK4(p0, 0, pa0); PK4(p0, 8, pa1); PK4(p1, 0, pa2); PK4(p1, 8, pa3);
#undef PK4
}
template <int DQK>
__device__ __forceinline__ void qkt(f32x16& p0, f32x16& p1, const char* Ks, const bf16x8 (&qr)[DQK / 16], int r32, int hi) {
  constexpr int KSTR = DQK * 2 + 16;
  p0 = f32x16{}; p1 = f32x16{};
#pragma unroll
  for (int d0 = 0; d0 < DQK / 16; ++d0) { const int cb = (d0 * 16 + hi * 8) * 2;
    bf16x8 b0 = *reinterpret_cast<const bf16x8*>(Ks + r32 * KSTR + cb);
    bf16x8 b1 = *reinterpret_cast<const bf16x8*>(Ks + (32 + r32) * KSTR + cb);
    p0 = __builtin_amdgcn_mfma_f32_32x32x16_bf16(b0, qr[d0], p0, 0, 0, 0);
    p1 = __builtin_amdgcn_mfma_f32_32x32x16_bf16(b1, qr[d0], p1, 0, 0, 0); }
}
template <int DV> __device__ __forceinline__ int v_st(int k, int c) { const int kk = (k & ~0xC) | ((k & 4) << 1) | ((k & 8) >> 1); return ((kk >> 3) * (DV / 32) + (c >> 5)) * 512 + ((kk & 7) * 32 + (c & 31)) * 2; }
__device__ __forceinline__ int v_rd_base(int lane) { return ((lane & 3) << 3) | (((lane >> 2) & 3) << 6) | (((lane >> 4) & 1) << 5) | (((lane >> 5) & 1) << 8); }
template <int DV> constexpr int v_rd_off(int d0, int ks, int half) { return d0 * 512 + (2 * ks + half) * (DV / 32) * 512; }
template <int OFF> __device__ __forceinline__ s16x4 tr_read(int vb) {
  s16x4 r; asm volatile("ds_read_b64_tr_b16 %0, %1 offset:%2" : "=&v"(r) : "v"(vb), "i"(OFF) : "memory"); return r;
}
template <int DV, int D0> __device__ __forceinline__ void pv_one(f32x16& od, int vb, bf16x8 pa0, bf16x8 pa1, bf16x8 pa2, bf16x8 pa3) {
  const s16x4 l0 = tr_read<v_rd_off<DV>(D0, 0, 0)>(vb), h0 = tr_read<v_rd_off<DV>(D0, 0, 1)>(vb), l1 = tr_read<v_rd_off<DV>(D0, 1, 0)>(vb), h1 = tr_read<v_rd_off<DV>(D0, 1, 1)>(vb);
  const s16x4 l2 = tr_read<v_rd_off<DV>(D0, 2, 0)>(vb), h2 = tr_read<v_rd_off<DV>(D0, 2, 1)>(vb), l3 = tr_read<v_rd_off<DV>(D0, 3, 0)>(vb), h3 = tr_read<v_rd_off<DV>(D0, 3, 1)>(vb);
  asm volatile("s_waitcnt lgkmcnt(0)" ::: "memory"); SBAR();
#define PK(L, H) (bf16x8){L[0], L[1], L[2], L[3], H[0], H[1], H[2], H[3]}
  od = __builtin_amdgcn_mfma_f32_32x32x16_bf16(pa0, PK(l0, h0), od, 0, 0, 0);
  od = __builtin_amdgcn_mfma_f32_32x32x16_bf16(pa1, PK(l1, h1), od, 0, 0, 0);
  od = __builtin_amdgcn_mfma_f32_32x32x16_bf16(pa2, PK(l2, h2), od, 0, 0, 0);
  od = __builtin_amdgcn_mfma_f32_32x32x16_bf16(pa3, PK(l3, h3), od, 0, 0, 0);
#undef PK
}
template <int DV> __device__ __forceinline__ void pv_all(f32x16 (&o)[DV / 32], int vb, bf16x8 pa0, bf16x8 pa1, bf16x8 pa2, bf16x8 pa3) {
  pv_one<DV, 0>(o[0], vb, pa0, pa1, pa2, pa3); pv_one<DV, 1>(o[1], vb, pa0, pa1, pa2, pa3);
  if constexpr (DV == 128) { pv_one<DV, 2>(o[2], vb, pa0, pa1, pa2, pa3); pv_one<DV, 3>(o[3], vb, pa0, pa1, pa2, pa3); }
}

struct KVSrc { const bf16_t* K; int ldk; const bf16_t* K2; int ldk2; const bf16_t* V; int ldv; };

template <int DQK, int DV>
__device__ __forceinline__ void attn_body(const bf16x8 (&qr)[DQK / 16], const KVSrc s, f32x16 (&o)[DV / 32], char* lds, int seq) {
  constexpr int KSTR = DQK * 2 + 16, SHM_V = 64 * DV * 2, SHM_K = 64 * KSTR;
  constexpr int NCHK = DQK / 8, NKI = (64 * NCHK + 511) / 512, NCHV = DV / 8, NVI = (64 * NCHV) / 512;
  const int tid = launder_i(threadIdx.x), wid = tid >> 6, lane = tid & 63, r32 = lane & 31, hi = lane >> 5;
  char* V_lds = lds; char* K_lds = lds + 2 * SHM_V;
  float* ws = (float*)(lds + 2 * SHM_V + 2 * SHM_K) + wid * 64; float* li_l = ws; float* al_l = ws + 32;
  float m_reg = -1e30f, l_reg = 0.f;
#pragma unroll
  for (int d = 0; d < DV / 32; ++d) o[d] = f32x16{};
  const bf16_t* kp[NKI]; long kstep[NKI]; int kdst[NKI]; bool kval[NKI];
#pragma unroll
  for (int i = 0; i < NKI; ++i) { const int c = tid + 512 * i; kval[i] = c < 64 * NCHK; const int cc = kval[i] ? c : 0; const int row = cc / NCHK, ch = cc % NCHK;
    if (ch < 8) { kp[i] = s.K + (long)row * s.ldk + ch * 8; kstep[i] = 64L * s.ldk; } else { kp[i] = s.K2 + (long)row * s.ldk2 + (ch - 8) * 8; kstep[i] = 64L * s.ldk2; }
    kdst[i] = row * KSTR + ch * 16; }
  const bf16_t* vp[NVI]; int vdst[NVI]; const long vstep = 64L * s.ldv;
#pragma unroll
  for (int i = 0; i < NVI; ++i) { const int c = tid + 512 * i; const int row = c / NCHV, ch = c % NCHV; vp[i] = s.V + (long)row * s.ldv + ch * 8; vdst[i] = v_st<DV>(row, ch * 8); }
  const int vb0 = (int)(uintptr_t)V_lds + v_rd_base(lane);
  bf16x8 sk0[NKI], sk1[NKI], sv0[NVI], sv1[NVI];
#define SLOAD(SK, SV, t) do { _Pragma("unroll") for (int i_ = 0; i_ < NKI; ++i_) SK[i_] = *reinterpret_cast<const bf16x8*>(kp[i_] + (long)(t) * kstep[i_]); \
    _Pragma("unroll") for (int i_ = 0; i_ < NVI; ++i_) SV[i_] = *reinterpret_cast<const bf16x8*>(vp[i_] + (long)(t) * vstep); } while (0)
#define SWRITE(b, SK, SV) do { _Pragma("unroll") for (int i_ = 0; i_ < NVI; ++i_) *(bf16x8*)(V_lds + (b) * SHM_V + vdst[i_]) = SV[i_]; \
    _Pragma("unroll") for (int i_ = 0; i_ < NKI; ++i_) if (kval[i_]) *(bf16x8*)(K_lds + (b) * SHM_K + kdst[i_]) = SK[i_]; } while (0)
#define SWAIT() asm volatile("s_waitcnt vmcnt(%0)" :: "n"(NKI + NVI) : "memory")
#define RESC(a) do { if (__any((a) < 1.f)) { if (hi == 0) al_l[r32] = (a); asm volatile("s_waitcnt lgkmcnt(0)" ::: "memory"); \
    _Pragma("unroll") for (int d = 0; d < DV / 32; ++d) _Pragma("unroll") for (int r = 0; r < 16; ++r) o[d][r] *= al_l[crow(r, hi)]; } } while (0)
  f32x16 pA0, pA1, pB0, pB1; float mnA, mnB, alA, alB; bf16x8 pa0, pa1, pa2, pa3; const int NT = seq / 64;
  __syncthreads();
  SLOAD(sk0, sv0, 0); asm volatile("s_waitcnt vmcnt(0)" ::: "memory"); SWRITE(0, sk0, sv0); __syncthreads();
  qkt<DQK>(pA0, pA1, K_lds, qr, r32, hi); partialSM(pA0, pA1, m_reg, mnA, alA);
  SLOAD(sk1, sv1, 1); if (2 < NT) SLOAD(sk0, sv0, 2);
  SWAIT(); SWRITE(1, sk1, sv1); __syncthreads();
  for (int j = 1; j + 1 < NT; j += 2) {
    SBAR(); qkt<DQK>(pB0, pB1, K_lds + SHM_K, qr, r32, hi);
    finishSM(pA0, pA1, alA, l_reg, pa0, pa1, pa2, pa3); SBAR();
    SLOAD(sk1, sv1, j + 2); SBAR();
    pv_all<DV>(o, vb0, pa0, pa1, pa2, pa3); partialSM(pB0, pB1, m_reg, mnB, alB);
    __syncthreads(); SWAIT(); SWRITE(0, sk0, sv0);
    RESC(alB); __syncthreads();
    SBAR(); qkt<DQK>(pA0, pA1, K_lds, qr, r32, hi);
    finishSM(pB0, pB1, alB, l_reg, pa0, pa1, pa2, pa3); SBAR();
    if (j + 3 < NT) SLOAD(sk0, sv0, j + 3); SBAR();
    pv_all<DV>(o, vb0 + SHM_V, pa0, pa1, pa2, pa3); partialSM(pA0, pA1, m_reg, mnA, alA);
    __syncthreads(); SWAIT(); SWRITE(1, sk1, sv1);
    RESC(alA); __syncthreads();
  }
  SBAR(); qkt<DQK>(pB0, pB1, K_lds + SHM_K, qr, r32, hi);
  finishSM(pA0, pA1, alA, l_reg, pa0, pa1, pa2, pa3); SBAR();
  pv_all<DV>(o, vb0, pa0, pa1, pa2, pa3); partialSM(pB0, pB1, m_reg, mnB, alB);
  __syncthreads(); RESC(alB);
  finishSM(pB0, pB1, alB, l_reg, pa0, pa1, pa2, pa3); SBAR();
  pv_all<DV>(o, vb0 + SHM_V, pa0, pa1, pa2, pa3);
  if (hi == 0) li_l[r32] = l_reg; asm volatile("s_waitcnt lgkmcnt(0)" ::: "memory");
#pragma unroll
  for (int r = 0; r < 16; ++r) { const float rl = __builtin_amdgcn_rcpf(li_l[crow(r, hi)]);
#pragma unroll
    for (int d = 0; d < DV / 32; ++d) o[d][r] *= rl; }
#undef SLOAD
#undef SWRITE
#undef SWAIT
#undef RESC
}
}

#define LAS __attribute__((address_space(3)))
typedef unsigned short bf16_t;
typedef unsigned v4u __attribute__((ext_vector_type(4)));
typedef unsigned v2u __attribute__((ext_vector_type(2)));
typedef float f32x4 __attribute__((ext_vector_type(4)));
typedef float f32x2 __attribute__((ext_vector_type(2)));

constexpr int NB = 8, SEQ = 4096, DM = 1024, NT_TOK = NB * SEQ;
constexpr int EV_IN = 3328, OD_INP = 1536;
constexpr float ALPHA = 1.6817928305074290f;
constexpr float LN_EPS = 1e-5f, RMS_EPS = 1e-6f;
constexpr float LOG2E = 1.4426950408889634f;
constexpr float QS_64 = 0.125f * LOG2E;
constexpr float QS_96 = 0.10206207261596575f * LOG2E;

constexpr size_t MiB = 1u << 20;
constexpr size_t WS_TAB = 0;
constexpr size_t TAB_A_COS = 0, TAB_A_SIN = 131072, TAB_C_COS = 262144, TAB_C_SIN = 524288, TAB_X_COS = 786432, TAB_X_SIN = 790528;
constexpr size_t WS_EVIN = 1 * MiB, SZ_EVIN = (size_t)EV_IN * 1024 * 2;
constexpr size_t WS_EVOUT = 14 * MiB, SZ_SQ = 2 * MiB;
constexpr size_t WS_ODIN = 18 * MiB, SZ_ODIN = 3 * MiB;
constexpr size_t WS_QB = 24 * MiB, SZ_QB = (size_t)1536 * 256 * 2;
constexpr size_t WS_KVB = 26 * MiB, SZ_KVB = (size_t)2048 * 128 * 2;
constexpr size_t WS_ODOUT = 27 * MiB;
constexpr size_t WS_XB = 32 * MiB;
constexpr size_t WS_OG = 96 * MiB;
constexpr size_t WS_Y = 160 * MiB;
constexpr size_t WS_H = 288 * MiB;
constexpr size_t WS_QC = WS_H, WS_GATE = WS_H + 96 * MiB, WS_CQN = WS_H + 160 * MiB, WS_CKVN = WS_H + 176 * MiB, WS_KRR = WS_H + 184 * MiB;
constexpr size_t WS_END = 496 * MiB;
constexpr int LDS_BYTES = 131072 + 1024;

struct Params {
  const float* x; const float* ev_w_in; const float* ev_w_out; const float* ev_lam; const float* ev_subln; const float* ev_qnorm; const float* ev_knorm;
  const float* ev_ln_g; const float* ev_ln_b; const float* od_w_in; const float* od_qnorm; const float* od_kvnorm; const float* od_w_qb; const float* od_w_kvb;
  const float* od_w_out; const float* od_ln_g; const float* od_ln_b; float* out; unsigned char* ws;
};

__device__ __forceinline__ unsigned f2bf_rne(float f) { unsigned u = __builtin_bit_cast(unsigned, f); return (u + 0x7fffu + ((u >> 16) & 1u)) >> 16; }
__device__ __forceinline__ unsigned pk2(float lo, float hi) { return f2bf_rne(lo) | (f2bf_rne(hi) << 16); }
__device__ __forceinline__ float wave_sum(float v) {
#pragma unroll
  for (int o = 1; o < 64; o <<= 1) v += __shfl_xor(v, o);
  return v;
}
__device__ __forceinline__ void transpose_item(const float* W, int K, int N, bf16_t* WT, int kb, int nb, int row_off, LAS float* scr, int lane) {
  const int k0 = 64 * kb, n0 = 32 * nb;
#pragma unroll 8
  for (int i = 0; i < 32; ++i) { const int kk = 2 * i + (lane >> 5); scr[kk * 33 + (lane & 31)] = W[(size_t)(k0 + kk) * N + n0 + (lane & 31)]; }
  asm volatile("s_waitcnt lgkmcnt(0)" ::: "memory");
  const int c = lane & 7;
#pragma unroll
  for (int j = 0; j < 4; ++j) { const int n = (lane >> 3) + 8 * j; const LAS float* s = scr + (8 * c) * 33 + n;
    v4u o; o.x = pk2(s[0 * 33], s[1 * 33]); o.y = pk2(s[2 * 33], s[3 * 33]); o.z = pk2(s[4 * 33], s[5 * 33]); o.w = pk2(s[6 * 33], s[7 * 33]);
    *(v4u*)(WT + (size_t)(row_off + n0 + n) * K + k0 + 8 * c) = o; }
  asm volatile("s_waitcnt lgkmcnt(0)" ::: "memory");
}
__device__ __forceinline__ void unpack8(v4u raw, float (&v)[8]) {
  v[0] = __uint_as_float(raw.x << 16); v[1] = __uint_as_float(raw.x & 0xffff0000u); v[2] = __uint_as_float(raw.y << 16); v[3] = __uint_as_float(raw.y & 0xffff0000u);
  v[4] = __uint_as_float(raw.z << 16); v[5] = __uint_as_float(raw.z & 0xffff0000u); v[6] = __uint_as_float(raw.w << 16); v[7] = __uint_as_float(raw.w & 0xffff0000u);
}
__device__ __forceinline__ v4u pack8(const float (&v)[8]) { v4u w; w.x = pk2(v[0], v[1]); w.y = pk2(v[2], v[3]); w.z = pk2(v[4], v[5]); w.w = pk2(v[6], v[7]); return w; }

typedef const __attribute__((address_space(4))) Params* CParams;
__device__ __forceinline__ CParams get_params() { CParams q = (CParams)__builtin_amdgcn_kernarg_segment_ptr(); asm volatile("" : "+s"(q)); return q; }
struct Ctx { int G, bid, vcu, GX, xcd, lcu, xmode, NGW; };
#define PHASE_IDS() const int tid = launder_i(threadIdx.x), lane = tid & 63, wave = __builtin_amdgcn_readfirstlane(tid >> 6), r32 = lane & 31, hi = lane >> 5; const int gw = C.vcu * 8 + wave; \
    (void)r32; (void)hi; (void)gw; (void)lane; CParams P = get_params(); unsigned char* ws = P->ws

__device__ __forceinline__ void phase_prologue(const Ctx C, unsigned char* lds) {
  PHASE_IDS();
  LAS float* scr = (LAS float*)((LAS unsigned char*)lds + wave * 16384);
  constexpr int I_EVIN = 16 * 104, I_SQ = 16 * 32, I_ODIN = 16 * 45, I_QB = 4 * 48, I_KVB = 2 * 64, PER = I_EVIN + I_SQ + I_ODIN + I_QB + I_KVB + I_SQ;
#pragma unroll 1
  for (int it = gw; it < 2 * PER; it += C.NGW) {
    const int i = it / PER; int r = it - i * PER;
    const float* W; int K, N, kb, nb, row_off = 0; bf16_t* WT;
    if (r < I_EVIN) { W = P->ev_w_in + (size_t)i * 1024 * EV_IN; K = 1024; N = EV_IN; WT = (bf16_t*)(ws + WS_EVIN + i * SZ_EVIN); kb = r / 104; nb = r % 104; }
    else if ((r -= I_EVIN) < I_SQ) { W = P->ev_w_out + (size_t)i * 1024 * 1024; K = 1024; N = 1024; WT = (bf16_t*)(ws + WS_EVOUT + i * SZ_SQ); kb = r / 32; nb = r % 32; }
    else if ((r -= I_SQ) < I_ODIN) { W = P->od_w_in + (size_t)i * 1024 * 1440; K = 1024; N = 1440; WT = (bf16_t*)(ws + WS_ODIN + i * SZ_ODIN); kb = r / 45; nb = r % 45; row_off = nb < 13 ? 0 : 96; }
    else if ((r -= I_ODIN) < I_QB) { W = P->od_w_qb + (size_t)i * 256 * 1536; K = 256; N = 1536; WT = (bf16_t*)(ws + WS_QB + i * SZ_QB); kb = r / 48; nb = r % 48; }
    else if ((r -= I_QB) < I_KVB) { W = P->od_w_kvb + (size_t)i * 128 * 2048; K = 128; N = 2048; WT = (bf16_t*)(ws + WS_KVB + i * SZ_KVB); kb = r / 64; nb = r % 64; }
    else { r -= I_KVB; W = P->od_w_out + (size_t)i * 1024 * 1024; K = 1024; N = 1024; WT = (bf16_t*)(ws + WS_ODOUT + i * SZ_SQ); kb = r / 32; nb = r % 32; }
    transpose_item(W, K, N, WT, kb, nb, row_off, scr, lane);
  }
  const int gt = C.vcu * 512 + tid, NGT = C.G * 512;
  for (int idx = gt; idx < 2 * 12288; idx += NGT) { const int i = idx / 12288, r = idx - i * 12288; *(v4u*)(ws + WS_ODIN + i * SZ_ODIN + (size_t)416 * 1024 * 2 + (size_t)r * 16) = (v4u){0u, 0u, 0u, 0u}; }
  for (int idx = gt; idx < 32768 + 65536 + 1024; idx += NGT) {
    int pos, fi, nf; float theta; float* tc; float* tsn;
    if (idx < 32768) { pos = idx >> 3; fi = idx & 7; nf = 8; theta = 500000.f; tc = (float*)(ws + TAB_A_COS) + idx; tsn = (float*)(ws + TAB_A_SIN) + idx; }
    else if (idx < 32768 + 65536) { const int k = idx - 32768; pos = k >> 4; fi = k & 15; nf = 16; theta = 500000.f; tc = (float*)(ws + TAB_C_COS) + k; tsn = (float*)(ws + TAB_C_SIN) + k; }
    else { const int k = idx - 32768 - 65536; pos = k >> 4; fi = k & 15; nf = 16; theta = 10000.f; tc = (float*)(ws + TAB_X_COS) + k; tsn = (float*)(ws + TAB_X_SIN) + k; }
    const float inv = (float)exp2(-(double)fi / (double)nf * log2((double)theta));
    const float ang = (float)pos * inv;
    double rev = (double)ang * 0.15915494309189535; rev -= floor(rev);
    const float rf = (float)rev;
    *tc = __builtin_amdgcn_cosf(rf); *tsn = __builtin_amdgcn_sinf(rf);
  }
  const float* x = P->x; bf16_t* XB = (bf16_t*)(ws + WS_XB);
#pragma unroll 2
  for (int idx = gt; idx < NT_TOK * DM / 8; idx += NGT) { const f32x4 a = *(const f32x4*)(x + (size_t)idx * 8), b = *(const f32x4*)(x + (size_t)idx * 8 + 4);
    v4u w; w.x = pk2(a[0], a[1]); w.y = pk2(a[2], a[3]); w.z = pk2(b[0], b[1]); w.w = pk2(b[2], b[3]); *(v4u*)(XB + (size_t)idx * 8) = w; }
}

__device__ __forceinline__ void phase_gemm_e1(const Ctx C, unsigned char* lds, int li) {
  CParams P = get_params(); unsigned char* ws = P->ws;
  pg8::Gemm g{(const bf16_t*)(ws + WS_XB), (const bf16_t*)(ws + WS_EVIN + li * SZ_EVIN), NT_TOK, EV_IN, 1024}; pg8::StaticOrder So; So.init(NT_TOK, EV_IN, C.G, C.bid);
  pg8::EpiBf16S E{(bf16_t*)(ws + WS_H), EV_IN, 2304, 1.f, 0};
#ifndef NO_E1
  pg8::gemm_phase<pg8::EpiBf16S, pg8::StaticOrder, true, true>((LAS unsigned char*)lds, g, So, E);
#endif
}
__device__ __forceinline__ void phase_gemm_o1(const Ctx C, unsigned char* lds, int li) {
  CParams P = get_params(); unsigned char* ws = P->ws;
  pg8::Gemm g{(const bf16_t*)(ws + WS_XB), (const bf16_t*)(ws + WS_ODIN + li * SZ_ODIN), NT_TOK, OD_INP, 1024}; pg8::StaticOrder So; So.init(NT_TOK, OD_INP, C.G, C.bid);
  pg8::EpiOddIn E{(float*)(ws + WS_OG), (bf16_t*)(ws + WS_GATE)};
#ifndef NO_O1
  pg8::gemm_phase<pg8::EpiOddIn, pg8::StaticOrder, true, true>((LAS unsigned char*)lds, g, So, E);
#endif
}
__device__ __forceinline__ void phase_gemm_o3(const Ctx C, unsigned char* lds, int li) {
#pragma unroll 1
  for (int which = 0; which < 2; ++which) {
    CParams P = get_params(); unsigned char* ws = P->ws;
    const int N = which ? 2048 : 1536, K = which ? 128 : 256;
    pg8::Gemm g{(const bf16_t*)(ws + (which ? WS_CKVN : WS_CQN)), (const bf16_t*)(ws + (which ? WS_KVB + li * SZ_KVB : WS_QB + li * SZ_QB)), NT_TOK, N, K};
    pg8::StaticOrder So; So.init(NT_TOK, N, C.G, C.bid);
    pg8::EpiBf16S E{(bf16_t*)(ws + (which ? WS_Y : WS_QC)), N, 1 << 30, which ? 1.f : QS_96, 1 << 30};
#ifndef NO_O3
    pg8::gemm_phase<pg8::EpiBf16S, pg8::StaticOrder, true, true>((LAS unsigned char*)lds, g, So, E);
#endif
  }
}
__device__ __forceinline__ void phase_gemm_out(const Ctx C, unsigned char* lds, int layer) {
  CParams P = get_params(); unsigned char* ws = P->ws;
  const bf16_t* Wt = (const bf16_t*)(ws + ((layer & 1) ? WS_ODOUT : WS_EVOUT) + (layer >> 1) * SZ_SQ);
  pg8::Gemm g{(const bf16_t*)(ws + WS_OG), Wt, NT_TOK, 1024, 1024}; pg8::StaticOrder So; So.init(NT_TOK, 1024, C.G, C.bid);
  pg8::EpiF32 E{(float*)(ws + WS_Y), 1024};
#ifndef NO_OUT
  pg8::gemm_phase<pg8::EpiF32, pg8::StaticOrder, true, true>((LAS unsigned char*)lds, g, So, E);
#endif
}

__device__ __forceinline__ void phase_e2(const Ctx C, int li) {
  PHASE_IDS();
  const int grp = (C.vcu * 512 + tid) >> 3, j = tid & 7, NGRP = C.G * 64;
  const float* qn = P->ev_qnorm + li * 64; const float* kn = P->ev_knorm + li * 64;
  bf16_t* H = (bf16_t*)(ws + WS_H);
  const float* tabAc = (const float*)(ws + TAB_A_COS); const float* tabAs = (const float*)(ws + TAB_A_SIN);
  const float* tabXc = (const float*)(ws + TAB_X_COS); const float* tabXs = (const float*)(ws + TAB_X_SIN);
#pragma unroll 1
  for (int it = grp; it < NT_TOK * 26; it += NGRP) {
    const int t = it / 26, ci = it - t * 26, pos = t & (SEQ - 1);
    const int col = ci < 16 ? ci * 64 : (ci < 24 ? 1536 + (ci - 16) * 64 : 2048 + (ci - 24) * 64);
    bf16_t* ptr = H + (size_t)t * EV_IN + col + j * 8;
    float v[8], pr[8]; unpack8(*(const v4u*)ptr, v);
    if (ci < 16) {
#pragma unroll
      for (int k = 0; k < 8; ++k) pr[k] = __shfl_xor(v[k], 1);
      if (j < 2) {
#pragma unroll
        for (int k = 0; k < 8; ++k) { const float c = tabAc[pos * 8 + k], s = tabAs[pos * 8 + k]; v[k] = j == 0 ? v[k] * c - pr[k] * s : v[k] * c + pr[k] * s; }
      }
    } else {
      float ss = 0.f;
#pragma unroll
      for (int k = 0; k < 8; ++k) ss += v[k] * v[k];
      ss += __shfl_xor(ss, 1); ss += __shfl_xor(ss, 2); ss += __shfl_xor(ss, 4);
      const float rinv = 1.0f / sqrtf(ss * (1.0f / 64.0f) + RMS_EPS);
      const float* g = ci < 24 ? qn : kn;
#pragma unroll
      for (int k = 0; k < 8; ++k) v[k] = v[k] * rinv * g[j * 8 + k];
#pragma unroll
      for (int k = 0; k < 8; ++k) pr[k] = __shfl_xor(v[k], 2);
      const int tp = (j < 4) ? (pos >> 6) : (pos & 63), fi = (j & 1) * 8;
#pragma unroll
      for (int k = 0; k < 8; ++k) { const float c = tabXc[tp * 16 + fi + k], s = tabXs[tp * 16 + fi + k]; v[k] = (j & 2) ? v[k] * c + pr[k] * s : v[k] * c - pr[k] * s; }
    }
    if (ci < 8 || (ci >= 16 && ci < 24)) {
#pragma unroll
      for (int k = 0; k < 8; ++k) v[k] *= QS_64;
    }
    *(v4u*)ptr = pack8(v);
  }
}

__device__ __forceinline__ void phase_e3(const Ctx C, unsigned char* lds, int layer) {
  const int li = layer >> 1;
  const float lam_init = layer == 0 ? 0.2f : 0.47071301834305566f;
#pragma unroll 1
  for (int s_ = 0;; ++s_) {
    int u; if (C.xmode) { const int idx = C.lcu + s_ * C.GX; if (idx >= 64) break; u = C.xcd * 64 + idx; } else { u = C.bid + s_ * C.G; if (u >= 512) break; }
    const int bh = u >> 4, qb = u & 15, b = bh >> 2, h = bh & 3;
    const size_t rowb = (size_t)b * SEQ;
    att::f32x16 o[4];
#pragma unroll 1
    for (int c = 0; c < 2; ++c) {
      PHASE_IDS();
      bf16_t* H = (bf16_t*)(ws + WS_H);
      const size_t roww = rowb + qb * 256 + wave * 32;
      att::bf16x8 qr[4];
      { const bf16_t* Qw = H + (roww + r32) * EV_IN + h * 128 + c * 64 + hi * 8;
#pragma unroll
        for (int d0 = 0; d0 < 4; ++d0) qr[d0] = *reinterpret_cast<const att::bf16x8*>(Qw + d0 * 16); }
      att::KVSrc kv{H + rowb * EV_IN + 512 + h * 128 + c * 64, EV_IN, nullptr, 0, H + rowb * EV_IN + 1024 + h * 128, EV_IN};
#ifndef NO_A
      att::attn_body<64, 128>(qr, kv, o, (char*)lds, SEQ);
#endif
      if (c == 0) {
        const int l2 = launder_i(threadIdx.x) & 63;
        float* scrA = (float*)(ws + WS_Y) + ((size_t)C.bid * 8 + wave) * 4096;
#pragma unroll
        for (int r = 0; r < 16; ++r) { float* pr_ = scrA + launder_i(r * 256 + l2);
#pragma unroll
          for (int d0 = 0; d0 < 4; ++d0) pr_[d0 * 64] = o[d0][r]; }
      }
    }
    {
      PHASE_IDS();
      float lam;
      { const float* lp = P->ev_lam + li * 256; const float d1 = wave_sum(lp[lane] * lp[64 + lane]), d2 = wave_sum(lp[128 + lane] * lp[192 + lane]); lam = expf(d1) - expf(d2) + lam_init; }
      const float* subln = P->ev_subln + li * 128;
      const bf16_t* H = (const bf16_t*)(ws + WS_H); bf16_t* OG = (bf16_t*)(ws + WS_OG);
      const float* scrA = (const float*)(ws + WS_Y) + ((size_t)C.bid * 8 + wave) * 4096;
      const size_t roww = rowb + qb * 256 + wave * 32;
      const float post = 1.0f - lam_init;
      float sl[4];
#pragma unroll
      for (int d0 = 0; d0 < 4; ++d0) sl[d0] = subln[d0 * 32 + r32];
#pragma unroll
      for (int r = 0; r < 16; ++r) {
        const float* pr_ = scrA + launder_i(r * 256 + lane);
        float ss = 0.f;
#pragma unroll
        for (int d0 = 0; d0 < 4; ++d0) { const float dlt = pr_[d0 * 64] - lam * o[d0][r]; o[d0][r] = dlt; ss += dlt * dlt; }
        ss += __shfl_xor(ss, 1); ss += __shfl_xor(ss, 2); ss += __shfl_xor(ss, 4); ss += __shfl_xor(ss, 8); ss += __shfl_xor(ss, 16);
        const float rinv = post / sqrtf(ss * (1.0f / 128.0f) + RMS_EPS);
        const size_t row = roww + launder_i(att::crow(r, hi));
        const bf16_t* gp = H + row * EV_IN + 2304 + h * 128 + r32; bf16_t* op = OG + row * 1024 + h * 128 + r32;
#pragma unroll
        for (int d0 = 0; d0 < 4; ++d0) op[d0 * 32] = att::f2bf(o[d0][r] * rinv * sl[d0] * att::bf2f(gp[d0 * 32]));
      }
    }
  }
#pragma unroll 1
  for (int s_ = 0;; ++s_) {
    int u; if (C.xmode) { const int idx = C.lcu + s_ * C.GX; if (idx >= 128) break; u = C.xcd * 128 + idx; } else { u = C.bid + s_ * C.G; if (u >= 1024) break; }
    const int bh = u >> 4, qb = u & 15, b = bh >> 3, hq = bh & 7, kvh = hq >> 2;
    const size_t rowb = (size_t)b * SEQ;
    att::f32x16 o[2];
    {
      PHASE_IDS();
      bf16_t* H = (bf16_t*)(ws + WS_H);
      const size_t roww = rowb + qb * 256 + wave * 32;
      att::bf16x8 qr[4];
      { const bf16_t* Qw = H + (roww + r32) * EV_IN + 1536 + hq * 64 + hi * 8;
#pragma unroll
        for (int d0 = 0; d0 < 4; ++d0) qr[d0] = *reinterpret_cast<const att::bf16x8*>(Qw + d0 * 16); }
      att::KVSrc kv{H + rowb * EV_IN + 2048 + kvh * 64, EV_IN, nullptr, 0, H + rowb * EV_IN + 2176 + kvh * 64, EV_IN};
#ifndef NO_B
      att::attn_body<64, 64>(qr, kv, o, (char*)lds, SEQ);
#endif
    }
    {
      PHASE_IDS();
      const bf16_t* H = (const bf16_t*)(ws + WS_H); bf16_t* OG = (bf16_t*)(ws + WS_OG);
      const size_t roww = rowb + qb * 256 + wave * 32;
#pragma unroll
      for (int r = 0; r < 16; ++r) { const size_t row = roww + launder_i(att::crow(r, hi));
        const bf16_t* gp = H + row * EV_IN + 2816 + hq * 64 + r32; bf16_t* op = OG + row * 1024 + 512 + hq * 64 + r32;
#pragma unroll
        for (int d0 = 0; d0 < 2; ++d0) op[d0 * 32] = att::f2bf(o[d0][r] * att::bf2f(gp[d0 * 32])); }
    }
  }
}

__device__ __forceinline__ void phase_o2(const Ctx C, int li) {
  PHASE_IDS();
  const float* qn = P->od_qnorm + li * 256; const float* kvn = P->od_kvnorm + li * 128;
  const float* HF = (const float*)(ws + WS_OG); bf16_t* CQN = (bf16_t*)(ws + WS_CQN); bf16_t* CKVN = (bf16_t*)(ws + WS_CKVN); bf16_t* KRR = (bf16_t*)(ws + WS_KRR);
  const float* tabCc = (const float*)(ws + TAB_C_COS); const float* tabCs = (const float*)(ws + TAB_C_SIN);
  const f32x4 gq = *(const f32x4*)(qn + 4 * lane); const f32x2 gk = *(const f32x2*)(kvn + 2 * lane);
#pragma unroll 2
  for (int t = gw; t < NT_TOK; t += C.NGW) {
    const float* hr = HF + (size_t)t * 512; const int pos = t & (SEQ - 1);
    const f32x4 a = *(const f32x4*)(hr + 4 * lane); const f32x2 c2 = *(const f32x2*)(hr + 256 + 2 * lane);
    const float sa = wave_sum((a[0] * a[0] + a[1] * a[1]) + (a[2] * a[2] + a[3] * a[3])), sc = wave_sum(c2[0] * c2[0] + c2[1] * c2[1]);
    const float ra = 1.0f / sqrtf(sa * (1.0f / 256.0f) + RMS_EPS), rc = 1.0f / sqrtf(sc * (1.0f / 128.0f) + RMS_EPS);
    v2u wq; wq.x = pk2(a[0] * ra * gq[0], a[1] * ra * gq[1]); wq.y = pk2(a[2] * ra * gq[2], a[3] * ra * gq[3]);
    *(v2u*)(CQN + (size_t)t * 256 + 4 * lane) = wq;
    *(unsigned*)(CKVN + (size_t)t * 128 + 2 * lane) = pk2(c2[0] * rc * gk[0], c2[1] * rc * gk[1]);
    if (lane < 16) { const float x1 = hr[384 + lane], x2 = hr[400 + lane], cs = tabCc[pos * 16 + lane], sn = tabCs[pos * 16 + lane];
      KRR[(size_t)t * 32 + lane] = (bf16_t)f2bf_rne(x1 * cs - x2 * sn); KRR[(size_t)t * 32 + 16 + lane] = (bf16_t)f2bf_rne(x2 * cs + x1 * sn); }
  }
}

__device__ __forceinline__ void phase_o4(const Ctx C, unsigned char* lds) {
#pragma unroll 1
  for (int s_ = 0;; ++s_) {
    int u; if (C.xmode) { const int idx = C.lcu + s_ * C.GX; if (idx >= 256) break; u = C.xcd * 256 + idx; } else { u = C.bid + s_ * C.G; if (u >= 2048) break; }
    const int bh = u >> 4, qb = u & 15, b = bh >> 4, h = bh & 15;
    const size_t rowb = (size_t)b * SEQ;
    att::f32x16 o[2];
    {
      PHASE_IDS();
      const bf16_t* QC = (const bf16_t*)(ws + WS_QC); const bf16_t* KVC = (const bf16_t*)(ws + WS_Y); const bf16_t* KRR = (const bf16_t*)(ws + WS_KRR);
      const float* tabCc = (const float*)(ws + TAB_C_COS); const float* tabCs = (const float*)(ws + TAB_C_SIN);
      const size_t roww = rowb + qb * 256 + wave * 32;
      att::bf16x8 qr[6];
      { const bf16_t* Qw = QC + (roww + r32) * 1536 + h * 96 + hi * 8;
#pragma unroll
        for (int d0 = 0; d0 < 6; ++d0) qr[d0] = *reinterpret_cast<const att::bf16x8*>(Qw + d0 * 16);
        const int pos = qb * 256 + wave * 32 + r32;
        float x1[8], x2[8]; unpack8(__builtin_bit_cast(v4u, qr[4]), x1); unpack8(__builtin_bit_cast(v4u, qr[5]), x2);
        float y1[8], y2[8];
#pragma unroll
        for (int k = 0; k < 8; ++k) { const float cs = tabCc[pos * 16 + 8 * hi + k], sn = tabCs[pos * 16 + 8 * hi + k]; y1[k] = x1[k] * cs - x2[k] * sn; y2[k] = x2[k] * cs + x1[k] * sn; }
        qr[4] = __builtin_bit_cast(att::bf16x8, pack8(y1)); qr[5] = __builtin_bit_cast(att::bf16x8, pack8(y2)); }
      att::KVSrc kv{KVC + rowb * 2048 + h * 128, 2048, KRR + rowb * 32, 32, KVC + rowb * 2048 + h * 128 + 64, 2048};
#ifndef NO_C
      att::attn_body<96, 64>(qr, kv, o, (char*)lds, SEQ);
#endif
    }
    {
      PHASE_IDS();
      const bf16_t* GATE = (const bf16_t*)(ws + WS_GATE); bf16_t* OG = (bf16_t*)(ws + WS_OG);
      const size_t roww = rowb + qb * 256 + wave * 32;
#pragma unroll
      for (int r = 0; r < 16; ++r) { const size_t row = roww + launder_i(att::crow(r, hi));
        const bf16_t* gp = GATE + row * 1024 + h * 64 + r32; bf16_t* op = OG + row * 1024 + h * 64 + r32;
#pragma unroll
        for (int d0 = 0; d0 < 2; ++d0) op[d0 * 32] = att::f2bf(o[d0][r] * att::bf2f(gp[d0 * 32])); }
    }
  }
}

__device__ __forceinline__ void phase_ln(const Ctx C, int layer) {
  PHASE_IDS();
  const int li = layer >> 1;
  const float* lg = ((layer & 1) ? P->od_ln_g : P->ev_ln_g) + li * 1024; const float* lb = ((layer & 1) ? P->od_ln_b : P->ev_ln_b) + li * 1024;
  const float* xin = layer == 0 ? P->x : P->out; float* out = P->out;
  const float* Y = (const float*)(ws + WS_Y); bf16_t* XB = (bf16_t*)(ws + WS_XB);
#pragma unroll 1
  for (int t = gw; t < NT_TOK; t += C.NGW) {
    const f32x4* xr = (const f32x4*)(xin + (size_t)t * 1024) + lane; const f32x4* yr = (const f32x4*)(Y + (size_t)t * 1024) + lane;
    f32x4 v[4]; float s = 0.f;
#pragma unroll
    for (int k = 0; k < 4; ++k) { v[k] = xr[64 * k] * ALPHA + yr[64 * k]; s += (v[k][0] + v[k][1]) + (v[k][2] + v[k][3]); }
    const float mean = wave_sum(s) * (1.0f / 1024.0f); float s2 = 0.f;
#pragma unroll
    for (int k = 0; k < 4; ++k) { v[k] = v[k] - mean; s2 += (v[k][0] * v[k][0] + v[k][1] * v[k][1]) + (v[k][2] * v[k][2] + v[k][3] * v[k][3]); }
    const float rstd = 1.0f / sqrtf(wave_sum(s2) * (1.0f / 1024.0f) + LN_EPS);
    f32x4* orow = (f32x4*)(out + (size_t)t * 1024) + lane; v2u* brow = (v2u*)(XB + (size_t)t * 1024) + lane;
#pragma unroll
    for (int k = 0; k < 4; ++k) { const f32x4 gg = *((const f32x4*)lg + lane + 64 * k), bb = *((const f32x4*)lb + lane + 64 * k);
      const f32x4 r = v[k] * rstd * gg + bb; orow[64 * k] = r; v2u w; w.x = pk2(r[0], r[1]); w.y = pk2(r[2], r[3]); brow[64 * k] = w; }
  }
}

__global__ void __launch_bounds__(512, 2) fwd_kernel(Params p_unused) {
  extern __shared__ __attribute__((aligned(16))) unsigned char lds[];
  cg::grid_group grid = cg::this_grid();
  Ctx C;
  C.G = gridDim.x; C.bid = blockIdx.x;
  C.xmode = ((C.G % 8 == 0) && (C.G >= 8)) ? 1 : 0;
  C.vcu = C.xmode ? (C.bid % 8) * (C.G / 8) + C.bid / 8 : C.bid;
  C.GX = C.xmode ? C.G / 8 : C.G; C.xcd = C.xmode ? C.vcu / C.GX : 0; C.lcu = C.xmode ? C.vcu % C.GX : 0;
  C.NGW = C.G * 8;
  phase_prologue(C, lds);
  grid.sync();
#pragma unroll 1
  for (int layer = 0; layer < 4; ++layer) {
    const int li = layer >> 1;
    if ((layer & 1) == 0) {
      phase_gemm_e1(C, lds, li); grid.sync();
      phase_e2(C, li); grid.sync();
      phase_e3(C, lds, layer);
    } else {
      phase_gemm_o1(C, lds, li); grid.sync();
      phase_o2(C, li); grid.sync();
      phase_gemm_o3(C, lds, li); grid.sync();
      phase_o4(C, lds);
    }
    grid.sync();
    phase_gemm_out(C, lds, layer); grid.sync();
    phase_ln(C, layer);
    if (layer < 3) grid.sync();
  }
}

extern "C" void kernel_launch(void* const* d_in, const int* in_sizes, int n_in, void* d_out, int out_size, void* d_ws, size_t ws_size, hipStream_t stream) {
  static int grid_blocks = 0;
  if (grid_blocks == 0) {
    if (n_in != 17 || in_sizes[0] != NT_TOK * DM || out_size != NT_TOK * DM || ws_size < WS_END) {
      fprintf(stderr, "kernel_launch: unexpected shapes: n_in %d in0 %d out %d ws %zu (need >= %zu)\n", n_in, n_in > 0 ? in_sizes[0] : -1, out_size, ws_size, (size_t)WS_END); grid_blocks = -1; return; }
    int dev = 0, cus = 0, per_cu = 0;
    hipGetDevice(&dev); hipDeviceGetAttribute(&cus, hipDeviceAttributeMultiprocessorCount, dev);
    if (hipFuncSetAttribute((const void*)fwd_kernel, hipFuncAttributeMaxDynamicSharedMemorySize, LDS_BYTES) != hipSuccess) { fprintf(stderr, "kernel_launch: hipFuncSetAttribute failed\n"); grid_blocks = -1; return; }
    if (hipOccupancyMaxActiveBlocksPerMultiprocessor(&per_cu, (const void*)fwd_kernel, 512, LDS_BYTES) != hipSuccess || per_cu < 1) { fprintf(stderr, "kernel_launch: occupancy query gave %d\n", per_cu); per_cu = 1; }
    (void)hipGetLastError();
    grid_blocks = cus * 1;
  }
  if (grid_blocks < 0) return;
  Params p{};
  p.x = (const float*)d_in[0]; p.ev_w_in = (const float*)d_in[1]; p.ev_w_out = (const float*)d_in[2]; p.ev_lam = (const float*)d_in[3]; p.ev_subln = (const float*)d_in[4];
  p.ev_qnorm = (const float*)d_in[5]; p.ev_knorm = (const float*)d_in[6]; p.ev_ln_g = (const float*)d_in[7]; p.ev_ln_b = (const float*)d_in[8]; p.od_w_in = (const float*)d_in[9];
  p.od_qnorm = (const float*)d_in[10]; p.od_kvnorm = (const float*)d_in[11]; p.od_w_qb = (const float*)d_in[12]; p.od_w_kvb = (const float*)d_in[13]; p.od_w_out = (const float*)d_in[14];
  p.od_ln_g = (const float*)d_in[15]; p.od_ln_b = (const float*)d_in[16]; p.out = (float*)d_out; p.ws = (unsigned char*)d_ws;
  void* args[] = {&p};
  hipError_t e = hipLaunchCooperativeKernel((const void*)fwd_kernel, dim3(grid_blocks), dim3(512), args, LDS_BYTES, stream);
  if (e != hipSuccess) fprintf(stderr, "kernel_launch: cooperative launch failed: %s (grid %d)\n", hipGetErrorString(e), grid_blocks);
}
```

```cpp
#include <hip/hip_runtime.h>
#include <hip/hip_cooperative_groups.h>
#include <cstdio>
#include <cstdint>
namespace cg = cooperative_groups;
__device__ __forceinline__ int launder_i(int v) { asm volatile("" : "+v"(v)); return v; }
namespace pg8 {
#define PG8_LAS __attribute__((address_space(3)))
typedef unsigned short bf16_t;
typedef short bf16x8 __attribute__((ext_vector_type(8)));
typedef float f32x4 __attribute__((ext_vector_type(4)));
typedef unsigned u32x4 __attribute__((ext_vector_type(4)));
constexpr int BM = 256, BK = 64, HALF = 128, HTB = HALF * BK * 2  , STAGE_BYTES = 8 * HTB, NXCD = 8, WGM = 8;

__host__ __device__ __forceinline__ int lds_byte(int r, int c) { const int st = (r >> 4) * 2 + (c >> 5), rr = r & 15, cc = c & 31, ob = rr * 64 + cc * 2; return st * 1024 + (ob ^ (((ob >> 9) & 1) << 5)); }
__host__ __device__ __forceinline__ void stage_rc(int b, int& R, int& C) { const int st = b / 1024, sb = b % 1024, swz = sb ^ (((sb >> 9) & 1) << 5); R = (st >> 1) * 16 + swz / 64; C = (st & 1) * 32 + (swz % 64) / 2; }
__host__ __device__ __forceinline__ int perm32(int rho) { const int n = rho >> 4, i = rho & 15; return 8 * (i >> 2) + 4 * n + (i & 3); }

struct Unit { int pm, pn; };
struct Gemm { const bf16_t* A; const bf16_t* Bt; int M, N, K; };

struct StaticOrder {
    int nM, nN, nwg, G, c;
    __host__ __device__ void init(int M, int N, int G_, int c_) { nM = M / BM; nN = N / BM; nwg = nM * nN; G = G_; c = c_; }
    __host__ __device__ bool next(int i, Unit& u) const {
        const long L = (long)i * G + c; if (L >= nwg) return false;
        int wgid = (int)L; { const int q = nwg / NXCD, r = nwg % NXCD, xcd = wgid % NXCD, off = wgid / NXCD; wgid = (xcd < r ? xcd * (q + 1) : r * (q + 1) + (xcd - r) * q) + off; }
        const int nig = WGM * nN, gid = wgid / nig, fm = gid * WGM, gsz = (nM - fm) < WGM ? (nM - fm) : WGM;
        u.pm = fm + ((wgid % nig) % gsz); u.pn = (wgid % nig) / gsz; return true;
    }
    __device__ __forceinline__ void a_ready(const Unit&) const {}
    __device__ __forceinline__ void done(const Unit&) const {}
};

__device__ __forceinline__ unsigned cvt_pk_bf16(float lo, float hi) { unsigned r; asm volatile("v_cvt_pk_bf16_f32 %0, %1, %2" : "=v"(r) : "v"(lo), "v"(hi)); return r; }
__device__ __forceinline__ float silu_f(float v) { return v * __builtin_amdgcn_rcpf(1.0f + __builtin_amdgcn_exp2f(-1.4426950408889634f * v)); }
__device__ __forceinline__ f32x4 silu4(f32x4 v) { return (f32x4){silu_f(v[0]), silu_f(v[1]), silu_f(v[2]), silu_f(v[3])}; }

struct EpiBf16S {
    static constexpr bool PERM = true, AFTER_DRAIN = false;
    bf16_t* O; int ldc; int silu_from; float scale; int scale_until;
    __device__ __forceinline__ void operator()(const f32x4 (&acc)[2][2][4][2], const Unit& u, int wr, int wc, int fr, int fq) const {
        const int row0 = u.pm * BM + wr * 64 + fr; const int colt = u.pn * BM;
        const bool act = colt >= silu_from; const float sc = colt < scale_until ? scale : 1.f;
        const int col0 = colt + wc * 32 + 8 * fq;
#pragma unroll
        for (int ai = 0; ai < 2; ++ai)
#pragma unroll
            for (int m = 0; m < 4; ++m) { bf16_t* rowp = O + (size_t)(row0 + ai * HALF + m * 16) * ldc + col0;
#pragma unroll
                for (int bj = 0; bj < 2; ++bj) { f32x4 v0 = acc[ai][bj][m][0], v1 = acc[ai][bj][m][1];
                    if (act) { v0 = silu4(v0); v1 = silu4(v1); }
                    v0 = v0 * sc; v1 = v1 * sc; u32x4 w; w.x = cvt_pk_bf16(v0[0], v0[1]); w.y = cvt_pk_bf16(v0[2], v0[3]); w.z = cvt_pk_bf16(v1[0], v1[1]); w.w = cvt_pk_bf16(v1[2], v1[3]);
                    *(u32x4*)(rowp + bj * HALF) = w; } }
    }
};
struct EpiOddIn {
    static constexpr bool PERM = true, AFTER_DRAIN = false;
    float* HF; bf16_t* G;
    __device__ __forceinline__ void operator()(const f32x4 (&acc)[2][2][4][2], const Unit& u, int wr, int wc, int fr, int fq) const {
        const int row0 = u.pm * BM + wr * 64 + fr; const int colt = u.pn * BM;
        const int col0 = colt + wc * 32 + 8 * fq;
        if (colt < 512) {
#pragma unroll
            for (int ai = 0; ai < 2; ++ai)
#pragma unroll
                for (int m = 0; m < 4; ++m) { float* rowp = HF + (size_t)(row0 + ai * HALF + m * 16) * 512 + col0;
#pragma unroll
                    for (int bj = 0; bj < 2; ++bj) { *(f32x4*)(rowp + bj * HALF) = acc[ai][bj][m][0]; *(f32x4*)(rowp + bj * HALF + 4) = acc[ai][bj][m][1]; } }
        } else {
#pragma unroll
            for (int ai = 0; ai < 2; ++ai)
#pragma unroll
                for (int m = 0; m < 4; ++m) { bf16_t* rowp = G + (size_t)(row0 + ai * HALF + m * 16) * 1024 + (col0 - 512);
#pragma unroll
                    for (int bj = 0; bj < 2; ++bj) { const f32x4 v0 = silu4(acc[ai][bj][m][0]), v1 = silu4(acc[ai][bj][m][1]);
                        u32x4 w; w.x = cvt_pk_bf16(v0[0], v0[1]); w.y = cvt_pk_bf16(v0[2], v0[3]); w.z = cvt_pk_bf16(v1[0], v1[1]); w.w = cvt_pk_bf16(v1[2], v1[3]);
                        *(u32x4*)(rowp + bj * HALF) = w; } }
        }
    }
};
struct EpiF32 {
    static constexpr bool PERM = false, AFTER_DRAIN = false;
    float* Y; int ldc;
    __device__ __forceinline__ void operator()(const f32x4 (&acc)[2][2][4][2], const Unit& u, int wr, int wc, int fr, int fq) const {
        const int row0 = u.pm * BM + wr * 64 + fr; const int col0 = u.pn * BM + wc * 32 + 4 * fq;
#pragma unroll
        for (int ai = 0; ai < 2; ++ai)
#pragma unroll
            for (int m = 0; m < 4; ++m) { float* rowp = Y + (size_t)(row0 + ai * HALF + m * 16) * ldc + col0;
#pragma unroll
                for (int bj = 0; bj < 2; ++bj)
#pragma unroll
                    for (int n = 0; n < 2; ++n) *(f32x4*)(rowp + bj * HALF + n * 16) = acc[ai][bj][m][n]; }
    }
};

template <class Epi, class Sched, bool ALIGN_EPI = false, bool SP2 = false>
__device__ __forceinline__ void gemm_phase(PG8_LAS unsigned char* lds, const Gemm g, const Sched& S, const Epi& E) {
    const int tid = launder_i(threadIdx.x), wid = __builtin_amdgcn_readfirstlane(tid >> 6), lane = tid & 63, wr = wid >> 2, wc = wid & 3, fr = lane & 15, fq = lane >> 4;
    const int K = g.K, nt = K / BK;
    unsigned voffA[2], voffB[2];
#pragma unroll
    for (int i = 0; i < 2; ++i) { int R, C; stage_rc(tid * 16 + i * 8192, R, C); const int Rb = Epi::PERM ? ((R & ~31) + perm32(R & 31)) : R;
        voffA[i] = (unsigned)(R * K + C) * 2u; voffB[i] = (unsigned)(Rb * K + C) * 2u; }
    const size_t kstep = (size_t)(BK * 2);
    const size_t hstep = (size_t)HALF * K * 2;
    const size_t tstep = 2 * hstep;
    const unsigned ldsw = (unsigned)wid * 1024u;
    const int aoff = lds_byte(wr * 64 + fr, fq * 8), boff = lds_byte(wc * 32 + fr, fq * 8);
#define PG8_SA(b, h) (((b) * 2 + (h)) * HTB)
#define PG8_SB(b, h) ((4 + (b) * 2 + (h)) * HTB)
#define PG8_STAGE(bufoff, gbase, voff) do { _Pragma("unroll") for (int _i = 0; _i < 2; ++_i) \
        __builtin_amdgcn_global_load_lds((const unsigned*)((const char*)(gbase) + (voff)[_i]), (PG8_LAS unsigned*)(lds + (bufoff) + ldsw + _i * 8192), 16, 0, 0); } while (0)
#define PG8_LDA(dst, b, h) do { _Pragma("unroll") for (int m = 0; m < 4; ++m) _Pragma("unroll") for (int k = 0; k < 2; ++k) dst[m][k] = *(const PG8_LAS bf16x8*)(lds + PG8_SA(b, h) + aoff + m * 2048 + k * 1024); } while (0)
#define PG8_LDB(dst, b, h) do { _Pragma("unroll") for (int n = 0; n < 2; ++n) _Pragma("unroll") for (int k = 0; k < 2; ++k) dst[n][k] = *(const PG8_LAS bf16x8*)(lds + PG8_SB(b, h) + boff + n * 2048 + k * 1024); } while (0)
#define PG8_MMA(ai, bj, At, Bt) do { __builtin_amdgcn_s_setprio(1); _Pragma("unroll") for (int m = 0; m < 4; ++m) _Pragma("unroll") for (int n = 0; n < 2; ++n) _Pragma("unroll") for (int k = 0; k < 2; ++k) \
        acc[ai][bj][m][n] = __builtin_amdgcn_mfma_f32_16x16x32_bf16(Bt[n][k], At[m][k], acc[ai][bj][m][n], 0, 0, 0); __builtin_amdgcn_s_setprio(0); } while (0)
#define PG8_WAIT_V(n) asm volatile("s_waitcnt vmcnt(" #n ")" ::: "memory")
#define PG8_WAIT_L(n) asm volatile("s_waitcnt lgkmcnt(" #n ")" ::: "memory")
#define PG8_BAR __builtin_amdgcn_s_barrier()
#define PG8_SCHED __builtin_amdgcn_sched_barrier(0)
    Unit cur, nxt; int ui = 0;
    if (!S.next(0, cur)) return;
    f32x4 acc[2][2][4][2];
#pragma unroll
    for (int a = 0; a < 2; ++a)
#pragma unroll
        for (int b = 0; b < 2; ++b)
#pragma unroll
            for (int m = 0; m < 4; ++m)
#pragma unroll
                for (int n = 0; n < 2; ++n) acc[a][b][m][n] = (f32x4){0.f, 0.f, 0.f, 0.f};
    bf16x8 At[4][2], B0[2][2], B1[2][2];
    const char* cA = (const char*)g.A + (size_t)cur.pm * tstep; const char* cB = (const char*)g.Bt + (size_t)cur.pn * tstep;
    S.a_ready(cur);
    if constexpr (SP2) {
        PG8_STAGE(PG8_SB(0, 0), cB, voffB); PG8_STAGE(PG8_SB(0, 1), cB + hstep, voffB); PG8_STAGE(PG8_SA(0, 0), cA, voffA); PG8_STAGE(PG8_SA(0, 1), cA + hstep, voffA);
        if (wr == 1) PG8_BAR;
        PG8_WAIT_V(2); PG8_BAR;
        PG8_STAGE(PG8_SB(1, 0), cB + kstep, voffB); PG8_STAGE(PG8_SA(1, 0), cA + kstep, voffA); PG8_STAGE(PG8_SB(1, 1), cB + hstep + kstep, voffB);
        PG8_WAIT_V(6); PG8_BAR;
    } else {
        PG8_STAGE(PG8_SB(0, 0), cB, voffB); PG8_STAGE(PG8_SA(0, 0), cA, voffA); PG8_STAGE(PG8_SB(0, 1), cB + hstep, voffB); PG8_STAGE(PG8_SA(0, 1), cA + hstep, voffA);
        if (wr == 1) PG8_BAR;
        PG8_WAIT_V(4); PG8_BAR;
        PG8_STAGE(PG8_SB(1, 0), cB + kstep, voffB); PG8_STAGE(PG8_SA(1, 0), cA + kstep, voffA); PG8_STAGE(PG8_SB(1, 1), cB + hstep + kstep, voffB);
        PG8_WAIT_V(6); PG8_BAR;
    }
    for (;;) {
        const bool has_next = S.next(ui + 1, nxt);
        const char* nA = has_next ? (const char*)g.A + (size_t)nxt.pm * tstep : cA; const char* nB = has_next ? (const char*)g.Bt + (size_t)nxt.pn * tstep : cB;
        for (int t = 0; t < nt; t += 2) {
            const bool last = (t == nt - 2);
            const char* a1 = cA + (size_t)(t + 1) * kstep;
            const char* a2 = last ? nA : cA + (size_t)(t + 2) * kstep; const char* b2 = last ? nB : cB + (size_t)(t + 2) * kstep;
            const char* a3 = a2 + kstep; const char* b3 = b2 + kstep;
            if (last && has_next) S.a_ready(nxt);
            if constexpr (SP2) {
            PG8_LDB(B0, 0, 0); PG8_LDB(B1, 0, 1); PG8_SCHED; PG8_LDA(At, 0, 0); PG8_STAGE(PG8_SA(1, 1), a1 + hstep, voffA);
            PG8_WAIT_V(8); PG8_WAIT_L(0); PG8_BAR; PG8_MMA(0, 0, At, B0); PG8_MMA(0, 1, At, B1); PG8_BAR; PG8_SCHED;
            PG8_LDA(At, 0, 1); PG8_STAGE(PG8_SB(0, 0), b2, voffB); PG8_STAGE(PG8_SB(0, 1), b2 + hstep, voffB); PG8_STAGE(PG8_SA(0, 0), a2, voffA);
            PG8_WAIT_V(8); PG8_WAIT_L(0); PG8_BAR; PG8_MMA(1, 0, At, B0); PG8_MMA(1, 1, At, B1); PG8_BAR; PG8_SCHED;
            PG8_LDB(B0, 1, 0); PG8_LDB(B1, 1, 1); PG8_SCHED; PG8_LDA(At, 1, 0); PG8_STAGE(PG8_SA(0, 1), a2 + hstep, voffA);
            PG8_WAIT_V(8); PG8_WAIT_L(0); PG8_BAR; PG8_MMA(0, 0, At, B0); PG8_MMA(0, 1, At, B1); PG8_BAR; PG8_SCHED;
            PG8_LDA(At, 1, 1); PG8_STAGE(PG8_SB(1, 0), b3, voffB); PG8_STAGE(PG8_SB(1, 1), b3 + hstep, voffB); PG8_STAGE(PG8_SA(1, 0), a3, voffA);
            PG8_WAIT_V(8); PG8_WAIT_L(0); PG8_BAR; PG8_MMA(1, 0, At, B0); PG8_MMA(1, 1, At, B1); PG8_BAR; PG8_SCHED;
            } else {
            PG8_LDB(B0, 0, 0); PG8_SCHED; PG8_LDA(At, 0, 0); PG8_STAGE(PG8_SA(1, 1), a1 + hstep, voffA);
            PG8_WAIT_L(8); PG8_BAR; PG8_WAIT_L(0); PG8_MMA(0, 0, At, B0); PG8_BAR; PG8_SCHED;
            PG8_LDB(B1, 0, 1); PG8_STAGE(PG8_SB(0, 0), b2, voffB);
            PG8_BAR; PG8_WAIT_L(0); PG8_MMA(0, 1, At, B1); PG8_BAR;
            PG8_LDA(At, 0, 1); PG8_STAGE(PG8_SA(0, 0), a2, voffA);
            PG8_BAR; PG8_WAIT_L(0); PG8_MMA(1, 0, At, B0); PG8_BAR; PG8_SCHED;
            PG8_STAGE(PG8_SB(0, 1), b2 + hstep, voffB);
            PG8_WAIT_V(6); PG8_BAR; PG8_MMA(1, 1, At, B1); PG8_BAR;
            PG8_LDB(B0, 1, 0); PG8_SCHED; PG8_LDA(At, 1, 0); PG8_STAGE(PG8_SA(0, 1), a2 + hstep, voffA);
            PG8_WAIT_L(8); PG8_BAR; PG8_WAIT_L(0); PG8_MMA(0, 0, At, B0); PG8_BAR; PG8_SCHED;
            PG8_LDB(B1, 1, 1); PG8_STAGE(PG8_SB(1, 0), b3, voffB);
            PG8_BAR; PG8_WAIT_L(0); PG8_MMA(0, 1, At, B1); PG8_BAR;
            PG8_LDA(At, 1, 1); PG8_STAGE(PG8_SA(1, 0), a3, voffA);
            PG8_BAR; PG8_WAIT_L(0); PG8_MMA(1, 0, At, B0); PG8_BAR; PG8_SCHED;
            PG8_STAGE(PG8_SB(1, 1), b3 + hstep, voffB);
            PG8_WAIT_V(6); PG8_BAR; PG8_MMA(1, 1, At, B1); PG8_BAR;
            }
        }
        if constexpr (ALIGN_EPI) { if (wr == 0) PG8_BAR; }
        if constexpr (!Epi::AFTER_DRAIN) { E(acc, cur, wr, wc, fr, fq); S.done(cur); }
        if (!has_next) break;
#pragma unroll
        for (int a = 0; a < 2; ++a)
#pragma unroll
            for (int b = 0; b < 2; ++b)
#pragma unroll
                for (int m = 0; m < 4; ++m)
#pragma unroll
                    for (int n = 0; n < 2; ++n) acc[a][b][m][n] = (f32x4){0.f, 0.f, 0.f, 0.f};
        cur = nxt; cA = nA; cB = nB; ++ui;
        if constexpr (ALIGN_EPI) { if (wr == 1) PG8_BAR; }
    }
    PG8_WAIT_V(0);
    if constexpr (!ALIGN_EPI) { if (wr == 0) PG8_BAR; }
    PG8_BAR;
    if constexpr (Epi::AFTER_DRAIN) { E.fused(acc, cur, wr, wc, fr, fq, lds, wid, lane); S.done(cur); }
#undef PG8_SA
#undef PG8_SB
#undef PG8_STAGE
#undef PG8_LDA
#undef PG8_LDB
#undef PG8_MMA
#undef PG8_WAIT_V
#undef PG8_WAIT_L
#undef PG8_BAR
#undef PG8_SCHED
}
}

namespace att {
typedef unsigned short bf16_t;
using bf16x8 = __attribute__((ext_vector_type(8))) short;
using s16x4  = __attribute__((ext_vector_type(4))) short;
using f32x16 = __attribute__((ext_vector_type(16))) float;
using u32x4  = __attribute__((ext_vector_type(4))) unsigned;
#define SBAR() __builtin_amdgcn_sched_barrier(0)
constexpr float THR = 8.f;
__device__ __forceinline__ int crow(int r, int hi) { return (r & 3) + 8 * (r >> 2) + 4 * hi; }
__device__ __forceinline__ unsigned cvtpk(float lo, float hi) { unsigned r; asm volatile("v_cvt_pk_bf16_f32 %0, %1, %2" : "=v"(r) : "v"(lo), "v"(hi)); return r; }
__device__ __forceinline__ float bf2f(bf16_t h) { return __uint_as_float(((unsigned)h) << 16); }
__device__ __forceinline__ bf16_t f2bf(float f) { return (bf16_t)(cvtpk(f, 0.f) & 0xffffu); }

__device__ __forceinline__ void partialSM(f32x16& p0, f32x16& p1, float& m_reg, float& mn, float& alpha) {
  float pmax = p0[0];
#pragma unroll
  for (int r = 1; r < 16; ++r) pmax = fmaxf(pmax, p0[r]);
#pragma unroll
  for (int r = 0; r < 16; ++r) pmax = fmaxf(pmax, p1[r]);
  { auto rr = __builtin_amdgcn_permlane32_swap(__float_as_uint(pmax), __float_as_uint(pmax), false, false);
    pmax = fmaxf(__uint_as_float(rr[0]), __uint_as_float(rr[1])); }
  if (__builtin_expect(__all(pmax - m_reg <= THR), 1)) { mn = m_reg; alpha = 1.f; }
  else { mn = fmaxf(m_reg, pmax); alpha = __builtin_amdgcn_exp2f(m_reg - mn); m_reg = mn; }
#pragma unroll
  for (int r = 0; r < 16; ++r) p0[r] = p0[r] - mn;
#pragma unroll
  for (int r = 0; r < 16; ++r) p1[r] = p1[r] - mn;
#pragma unroll
  for (int r = 0; r < 16; ++r) p0[r] = __builtin_amdgcn_exp2f(p0[r]);
}
__device__ __forceinline__ void finishSM(f32x16& p0, f32x16& p1, float alpha, float& l_reg, bf16x8& pa0, bf16x8& pa1, bf16x8& pa2, bf16x8& pa3) {
#pragma unroll
  for (int r = 0; r < 16; ++r) p1[r] = __builtin_amdgcn_exp2f(p1[r]);
  float ps = 0;
#pragma unroll
  for (int r = 0; r < 16; ++r) ps += p0[r];
#pragma unroll
  for (int r = 0; r < 16; ++r) ps += p1[r];
  { auto rr = __builtin_amdgcn_permlane32_swap(__float_as_uint(ps), __float_as_uint(ps), false, false);
    ps = __uint_as_float(rr[0]) + __uint_as_float(rr[1]); }
  l_reg = l_reg * alpha + ps;
#define PK4(P, BASE, OUT) do { unsigned a0 = cvtpk(P[BASE + 0], P[BASE + 1]), a1 = cvtpk(P[BASE + 2], P[BASE + 3]);   \
    unsigned b0 = cvtpk(P[BASE + 4], P[BASE + 5]), b1 = cvtpk(P[BASE + 6], P[BASE + 7]);                              \
    auto r0 = __builtin_amdgcn_permlane32_swap(a0, b0, false, false); auto r1 = __builtin_amdgcn_permlane32_swap(a1, b1, false, false); \
    u32x4 w = {r0[0], r1[0], r0[1], r1[1]}; OUT = *reinterpret_cast<bf16x8*>(&w); } while (0)
  PK4(p0, 0, pa0); PK4(p0, 8, pa1); PK4(p1, 0, pa2); PK4(p1, 8, pa3);
#undef PK4
}
template <int DQK>
__device__ __forceinline__ void qkt(f32x16& p0, f32x16& p1, const char* Ks, const bf16x8 (&qr)[DQK / 16], int r32, int hi) {
  constexpr int KSTR = DQK * 2 + 16;
  p0 = f32x16{}; p1 = f32x16{};
#pragma unroll
  for (int d0 = 0; d0 < DQK / 16; ++d0) { const int cb = (d0 * 16 + hi * 8) * 2;
    bf16x8 b0 = *reinterpret_cast<const bf16x8*>(Ks + r32 * KSTR + cb);
    bf16x8 b1 = *reinterpret_cast<const bf16x8*>(Ks + (32 + r32) * KSTR + cb);
    p0 = __builtin_amdgcn_mfma_f32_32x32x16_bf16(b0, qr[d0], p0, 0, 0, 0);
    p1 = __builtin_amdgcn_mfma_f32_32x32x16_bf16(b1, qr[d0], p1, 0, 0, 0); }
}
template <int DV> __device__ __forceinline__ int v_st(int k, int c) { const int kk = (k & ~0xC) | ((k & 4) << 1) | ((k & 8) >> 1); return ((kk >> 3) * (DV / 32) + (c >> 5)) * 512 + ((kk & 7) * 32 + (c & 31)) * 2; }
__device__ __forceinline__ int v_rd_base(int lane) { return ((lane & 3) << 3) | (((lane >> 2) & 3) << 6) | (((lane >> 4) & 1) << 5) | (((lane >> 5) & 1) << 8); }
template <int DV> constexpr int v_rd_off(int d0, int ks, int half) { return d0 * 512 + (2 * ks + half) * (DV / 32) * 512; }
template <int OFF> __device__ __forceinline__ s16x4 tr_read(int vb) {
  s16x4 r; asm volatile("ds_read_b64_tr_b16 %0, %1 offset:%2" : "=&v"(r) : "v"(vb), "i"(OFF) : "memory"); return r;
}
template <int DV, int D0> __device__ __forceinline__ void pv_one(f32x16& od, int vb, bf16x8 pa0, bf16x8 pa1, bf16x8 pa2, bf16x8 pa3) {
  const s16x4 l0 = tr_read<v_rd_off<DV>(D0, 0, 0)>(vb), h0 = tr_read<v_rd_off<DV>(D0, 0, 1)>(vb), l1 = tr_read<v_rd_off<DV>(D0, 1, 0)>(vb), h1 = tr_read<v_rd_off<DV>(D0, 1, 1)>(vb);
  const s16x4 l2 = tr_read<v_rd_off<DV>(D0, 2, 0)>(vb), h2 = tr_read<v_rd_off<DV>(D0, 2, 1)>(vb), l3 = tr_read<v_rd_off<DV>(D0, 3, 0)>(vb), h3 = tr_read<v_rd_off<DV>(D0, 3, 1)>(vb);
  asm volatile("s_waitcnt lgkmcnt(0)" ::: "memory"); SBAR();
#define PK(L, H) (bf16x8){L[0], L[1], L[2], L[3], H[0], H[1], H[2], H[3]}
  od = __builtin_amdgcn_mfma_f32_32x32x16_bf16(pa0, PK(l0, h0), od, 0, 0, 0);
  od = __builtin_amdgcn_mfma_f32_32x32x16_bf16(pa1, PK(l1, h1), od, 0, 0, 0);
  od = __builtin_amdgcn_mfma_f32_32x32x16_bf16(pa2, PK(l2, h2), od, 0, 0, 0);
  od = __builtin_amdgcn_mfma_f32_32x32x16_bf16(pa3, PK(l3, h3), od, 0, 0, 0);
#undef PK
}
template <int DV> __device__ __forceinline__ void pv_all(f32x16 (&o)[DV / 32], int vb, bf16x8 pa0, bf16x8 pa1, bf16x8 pa2, bf16x8 pa3) {
  pv_one<DV, 0>(o[0], vb, pa0, pa1, pa2, pa3); pv_one<DV, 1>(o[1], vb, pa0, pa1, pa2, pa3);
  if constexpr (DV == 128) { pv_one<DV, 2>(o[2], vb, pa0, pa1, pa2, pa3); pv_one<DV, 3>(o[3], vb, pa0, pa1, pa2, pa3); }
}

struct KVSrc { const bf16_t* K; int ldk; const bf16_t* K2; int ldk2; const bf16_t* V; int ldv; };

template <int DQK, int DV>
__device__ __forceinline__ void attn_body(const bf16x8 (&qr)[DQK / 16], const KVSrc s, f32x16 (&o)[DV / 32], char* lds, int seq) {
  constexpr int KSTR = DQK * 2 + 16, SHM_V = 64 * DV * 2, SHM_K = 64 * KSTR;
  constexpr int NCHK = DQK / 8, NKI = (64 * NCHK + 511) / 512, NCHV = DV / 8, NVI = (64 * NCHV) / 512;
  const int tid = launder_i(threadIdx.x), wid = tid >> 6, lane = tid & 63, r32 = lane & 31, hi = lane >> 5;
  char* V_lds = lds; char* K_lds = lds + 2 * SHM_V;
  float* ws = (float*)(lds + 2 * SHM_V + 2 * SHM_K) + wid * 64; float* li_l = ws; float* al_l = ws + 32;
  float m_reg = -1e30f, l_reg = 0.f;
#pragma unroll
  for (int d = 0; d < DV / 32; ++d) o[d] = f32x16{};
  const bf16_t* kp[NKI]; long kstep[NKI]; int kdst[NKI]; bool kval[NKI];
#pragma unroll
  for (int i = 0; i < NKI; ++i) { const int c = tid + 512 * i; kval[i] = c < 64 * NCHK; const int cc = kval[i] ? c : 0; const int row = cc / NCHK, ch = cc % NCHK;
    if (ch < 8) { kp[i] = s.K + (long)row * s.ldk + ch * 8; kstep[i] = 64L * s.ldk; } else { kp[i] = s.K2 + (long)row * s.ldk2 + (ch - 8) * 8; kstep[i] = 64L * s.ldk2; }
    kdst[i] = row * KSTR + ch * 16; }
  const bf16_t* vp[NVI]; int vdst[NVI]; const long vstep = 64L * s.ldv;
#pragma unroll
  for (int i = 0; i < NVI; ++i) { const int c = tid + 512 * i; const int row = c / NCHV, ch = c % NCHV; vp[i] = s.V + (long)row * s.ldv + ch * 8; vdst[i] = v_st<DV>(row, ch * 8); }
  const int vb0 = (int)(uintptr_t)V_lds + v_rd_base(lane);
  bf16x8 sk0[NKI], sk1[NKI], sv0[NVI], sv1[NVI];
#define SLOAD(SK, SV, t) do { _Pragma("unroll") for (int i_ = 0; i_ < NKI; ++i_) SK[i_] = *reinterpret_cast<const bf16x8*>(kp[i_] + (long)(t) * kstep[i_]); \
    _Pragma("unroll") for (int i_ = 0; i_ < NVI; ++i_) SV[i_] = *reinterpret_cast<const bf16x8*>(vp[i_] + (long)(t) * vstep); } while (0)
#define SWRITE(b, SK, SV) do { _Pragma("unroll") for (int i_ = 0; i_ < NVI; ++i_) *(bf16x8*)(V_lds + (b) * SHM_V + vdst[i_]) = SV[i_]; \
    _Pragma("unroll") for (int i_ = 0; i_ < NKI; ++i_) if (kval[i_]) *(bf16x8*)(K_lds + (b) * SHM_K + kdst[i_]) = SK[i_]; } while (0)
#define SWAIT() asm volatile("s_waitcnt vmcnt(%0)" :: "n"(NKI + NVI) : "memory")
#define RESC(a) do { if (__any((a) < 1.f)) { if (hi == 0) al_l[r32] = (a); asm volatile("s_waitcnt lgkmcnt(0)" ::: "memory"); \
    _Pragma("unroll") for (int d = 0; d < DV / 32; ++d) _Pragma("unroll") for (int r = 0; r < 16; ++r) o[d][r] *= al_l[crow(r, hi)]; } } while (0)
  f32x16 pA0, pA1, pB0, pB1; float mnA, mnB, alA, alB; bf16x8 pa0, pa1, pa2, pa3; const int NT = seq / 64;
  __syncthreads();
  SLOAD(sk0, sv0, 0); asm volatile("s_waitcnt vmcnt(0)" ::: "memory"); SWRITE(0, sk0, sv0); __syncthreads();
  qkt<DQK>(pA0, pA1, K_lds, qr, r32, hi); partialSM(pA0, pA1, m_reg, mnA, alA);
  SLOAD(sk1, sv1, 1); if (2 < NT) SLOAD(sk0, sv0, 2);
  SWAIT(); SWRITE(1, sk1, sv1); __syncthreads();
  for (int j = 1; j + 1 < NT; j += 2) {
    SBAR(); qkt<DQK>(pB0, pB1, K_lds + SHM_K, qr, r32, hi);
    finishSM(pA0, pA1, alA, l_reg, pa0, pa1, pa2, pa3); SBAR();
    SLOAD(sk1, sv1, j + 2); SBAR();
    pv_all<DV>(o, vb0, pa0, pa1, pa2, pa3); partialSM(pB0, pB1, m_reg, mnB, alB);
    __syncthreads(); SWAIT(); SWRITE(0, sk0, sv0);
    RESC(alB); __syncthreads();
    SBAR(); qkt<DQK>(pA0, pA1, K_lds, qr, r32, hi);
    finishSM(pB0, pB1, alB, l_reg, pa0, pa1, pa2, pa3); SBAR();
    if (j + 3 < NT) SLOAD(sk0, sv0, j + 3); SBAR();
    pv_all<DV>(o, vb0 + SHM_V, pa0, pa1, pa2, pa3); partialSM(pA0, pA1, m_reg, mnA, alA);
    __syncthreads(); SWAIT(); SWRITE(1, sk1, sv1);
    RESC(alA); __syncthreads();
  }
  SBAR(); qkt<DQK>(pB0, pB1, K_lds + SHM_K, qr, r32, hi);
  finishSM(pA0, pA1, alA, l_reg, pa0, pa1, pa2, pa3); SBAR();
  pv_all<DV>(o, vb0, pa0, pa1, pa2, pa3); partialSM(pB0, pB1, m_reg, mnB, alB);
  __syncthreads(); RESC(alB);
  finishSM(pB0, pB1, alB, l_reg, pa0, pa1, pa2, pa3); SBAR();
  pv_all<DV>(o, vb0 + SHM_V, pa0, pa1, pa2, pa3);
  if (hi == 0) li_l[r32] = l_reg; asm volatile("s_waitcnt lgkmcnt(0)" ::: "memory");
#pragma unroll
  for (int r = 0; r < 16; ++r) { const float rl = __builtin_amdgcn_rcpf(li_l[crow(r, hi)]);
#pragma unroll
    for (int d = 0; d < DV / 32; ++d) o[d][r] *= rl; }
#undef SLOAD
#undef SWRITE
#undef SWAIT
#undef RESC
}
}

#define LAS __attribute__((address_space(3)))
typedef unsigned short bf16_t;
typedef unsigned v4u __attribute__((ext_vector_type(4)));
typedef unsigned v2u __attribute__((ext_vector_type(2)));
typedef float f32x4 __attribute__((ext_vector_type(4)));
typedef float f32x2 __attribute__((ext_vector_type(2)));

constexpr int NB = 8, SEQ = 4096, DM = 1024, NT_TOK = NB * SEQ;
constexpr int EV_IN = 3328, OD_INP = 1536;
constexpr float ALPHA = 1.6817928305074290f;
constexpr float LN_EPS = 1e-5f, RMS_EPS = 1e-6f;
constexpr float LOG2E = 1.4426950408889634f;
constexpr float QS_64 = 0.125f * LOG2E;
constexpr float QS_96 = 0.10206207261596575f * LOG2E;

constexpr size_t MiB = 1u << 20;
constexpr size_t WS_TAB = 0;
constexpr size_t TAB_A_COS = 0, TAB_A_SIN = 131072, TAB_C_COS = 262144, TAB_C_SIN = 524288, TAB_X_COS = 786432, TAB_X_SIN = 790528;
constexpr size_t WS_BAR = 917504, WS_BAR_BYTES = 16384;
constexpr size_t WS_EVIN = 1 * MiB, SZ_EVIN = (size_t)EV_IN * 1024 * 2;
constexpr size_t WS_EVOUT = 14 * MiB, SZ_SQ = 2 * MiB;
constexpr size_t WS_ODIN = 18 * MiB, SZ_ODIN = 3 * MiB;
constexpr size_t WS_QB = 24 * MiB, SZ_QB = (size_t)1536 * 256 * 2;
constexpr size_t WS_KVB = 26 * MiB, SZ_KVB = (size_t)2048 * 128 * 2;
constexpr size_t WS_ODOUT = 27 * MiB;
constexpr size_t WS_XB = 32 * MiB;
constexpr size_t WS_OG = 96 * MiB;
constexpr size_t WS_Y = 160 * MiB;
constexpr size_t WS_H = 288 * MiB;
constexpr size_t WS_QC = WS_H, WS_GATE = WS_H + 96 * MiB, WS_CQN = WS_H + 160 * MiB, WS_CKVN = WS_H + 176 * MiB, WS_KRR = WS_H + 184 * MiB;
constexpr size_t WS_END = 496 * MiB;
constexpr int LDS_BYTES = 131072 + 1024;

struct Params {
  const float* x; const float* ev_w_in; const float* ev_w_out; const float* ev_lam; const float* ev_subln; const float* ev_qnorm; const float* ev_knorm;
  const float* ev_ln_g; const float* ev_ln_b; const float* od_w_in; const float* od_qnorm; const float* od_kvnorm; const float* od_w_qb; const float* od_w_kvb;
  const float* od_w_out; const float* od_ln_g; const float* od_ln_b; float* out; unsigned char* ws;
};

__device__ __forceinline__ unsigned f2bf_rne(float f) { unsigned u = __builtin_bit_cast(unsigned, f); return (u + 0x7fffu + ((u >> 16) & 1u)) >> 16; }
__device__ __forceinline__ unsigned pk2(float lo, float hi) { return f2bf_rne(lo) | (f2bf_rne(hi) << 16); }
__device__ __forceinline__ float wave_sum(float v) {
#pragma unroll
  for (int o = 1; o < 64; o <<= 1) v += __shfl_xor(v, o);
  return v;
}
__device__ __forceinline__ void transpose_item(const float* W, int K, int N, bf16_t* WT, int kb, int nb, int row_off, LAS float* scr, int lane) {
  const int k0 = 64 * kb, n0 = 32 * nb;
#pragma unroll 8
  for (int i = 0; i < 32; ++i) { const int kk = 2 * i + (lane >> 5); scr[kk * 33 + (lane & 31)] = W[(size_t)(k0 + kk) * N + n0 + (lane & 31)]; }
  asm volatile("s_waitcnt lgkmcnt(0)" ::: "memory");
  const int c = lane & 7;
#pragma unroll
  for (int j = 0; j < 4; ++j) { const int n = (lane >> 3) + 8 * j; const LAS float* s = scr + (8 * c) * 33 + n;
    v4u o; o.x = pk2(s[0 * 33], s[1 * 33]); o.y = pk2(s[2 * 33], s[3 * 33]); o.z = pk2(s[4 * 33], s[5 * 33]); o.w = pk2(s[6 * 33], s[7 * 33]);
    *(v4u*)(WT + (size_t)(row_off + n0 + n) * K + k0 + 8 * c) = o; }
  asm volatile("s_waitcnt lgkmcnt(0)" ::: "memory");
}
__device__ __forceinline__ void unpack8(v4u raw, float (&v)[8]) {
  v[0] = __uint_as_float(raw.x << 16); v[1] = __uint_as_float(raw.x & 0xffff0000u); v[2] = __uint_as_float(raw.y << 16); v[3] = __uint_as_float(raw.y & 0xffff0000u);
  v[4] = __uint_as_float(raw.z << 16); v[5] = __uint_as_float(raw.z & 0xffff0000u); v[6] = __uint_as_float(raw.w << 16); v[7] = __uint_as_float(raw.w & 0xffff0000u);
}
__device__ __forceinline__ v4u pack8(const float (&v)[8]) { v4u w; w.x = pk2(v[0], v[1]); w.y = pk2(v[2], v[3]); w.z = pk2(v[4], v[5]); w.w = pk2(v[6], v[7]); return w; }

#define XB_TMO      128
#define XB_XCNT(j)  (256  + 64 * (j))
#define XB_XSUB(j)  (1280 + 64 * (j))
#define XB_XGEN(j)  (2304 + 64 * (j))
#define XB_TOP      3328
#define XB_TOPGEN   3392
#define XCD_BAR_WORDS 3456
#define XB_SPIN_CAP (1u << 18)

__device__ __forceinline__ unsigned xb_ld(unsigned* p)              { return __hip_atomic_load(p, __ATOMIC_RELAXED, __HIP_MEMORY_SCOPE_AGENT); }
__device__ __forceinline__ unsigned xb_add(unsigned* p, unsigned v) { return __hip_atomic_fetch_add(p, v, __ATOMIC_RELAXED, __HIP_MEMORY_SCOPE_AGENT); }
__device__ __forceinline__ unsigned xb_xcc_id() { return (unsigned)__builtin_amdgcn_s_getreg((3 << 11) | 20) & 0xFu; }
#define XB_SPIN(cond, bar) do { unsigned _sp = 0; while (cond) { __builtin_amdgcn_s_sleep(1); \
    if ((++_sp & 255u) == 0u) { if (xb_ld(&(bar)[XB_TMO])) break; if (_sp > XB_SPIN_CAP) { atomicAdd(&(bar)[XB_TMO], 1u); break; } } } } while (0)

struct XcdBarrier {
    unsigned* bar; unsigned x;
    volatile LAS unsigned* st;
};

__device__ __forceinline__ XcdBarrier xcd_barrier_post(unsigned* bar, volatile LAS unsigned* st) {
    XcdBarrier b; b.bar = bar; b.x = xb_xcc_id(); b.st = st;
    if (threadIdx.x == 0) (void)xb_add(&bar[XB_XCNT(b.x)], 1u);
    return b;
}
__device__ __forceinline__ void xcd_barrier_complete(unsigned* bar, unsigned x, unsigned& nloc, unsigned& nx) {
    const unsigned G = gridDim.x * gridDim.y * gridDim.z;
    unsigned sum, cnt, mine, sp = 0u;
    for (;;) {
        sum = 0u; cnt = 0u; mine = 0u;
#pragma unroll
        for (unsigned j = 0; j < 16; ++j) { const unsigned c = xb_ld(&bar[XB_XCNT(j)]); sum += c; cnt += (c > 0u) ? 1u : 0u; mine = (j == x) ? c : mine; }
        if (sum == G) break;
        __builtin_amdgcn_s_sleep(1);
        if ((++sp & 255u) == 0u) { if (xb_ld(&bar[XB_TMO])) break; if (sp > XB_SPIN_CAP) { atomicAdd(&bar[XB_TMO], 1u); break; } }
    }
    nloc = mine > 0u ? mine : 1u; nx = cnt > 0u ? cnt : 1u;
}

__device__ __forceinline__ void xcd_barrier(const XcdBarrier& b) {
    asm volatile("s_waitcnt vmcnt(0)" ::: "memory");
    __syncthreads();
    if (threadIdx.x == 0) {
        unsigned* bar = b.bar;
        __builtin_amdgcn_s_waitcnt(0);
        unsigned nloc = b.st[0], nx = b.st[1];
        if (nloc == 0u) { xcd_barrier_complete(bar, b.x, nloc, nx); b.st[0] = nloc; b.st[1] = nx; }
        const unsigned old = xb_add(&bar[XB_XSUB(b.x)], 1u);
        const unsigned gen = old / nloc;
        if (old + 1u == (gen + 1u) * nloc) {
            __builtin_amdgcn_fence(__ATOMIC_RELEASE, "agent");
            asm volatile("s_waitcnt vmcnt(0)" ::: "memory");
            const unsigned og = xb_add(&bar[XB_TOP], 1u);
            const unsigned tg = og / nx;
            if (og + 1u == (tg + 1u) * nx) xb_add(&bar[XB_TOPGEN], 1u);
            else XB_SPIN(xb_ld(&bar[XB_TOPGEN]) == tg, bar);
            __builtin_amdgcn_fence(__ATOMIC_ACQUIRE, "agent");
            xb_add(&bar[XB_XGEN(b.x)], 1u);
            asm volatile("s_waitcnt vmcnt(0)" ::: "memory");
        } else {
            XB_SPIN(xb_ld(&bar[XB_XGEN(b.x)]) == gen, bar);
            __builtin_amdgcn_fence(__ATOMIC_ACQUIRE, "agent");
            asm volatile("s_waitcnt vmcnt(0)" ::: "memory");
        }
    }
    __syncthreads();
}
#ifdef REP_SYNC
#define GSYNC() do { for (int rs_ = 0; rs_ < REP_SYNC; ++rs_) xcd_barrier(bar); } while (0)
#else
#define GSYNC() xcd_barrier(bar)
#endif
typedef const __attribute__((address_space(4))) Params* CParams;
__device__ __forceinline__ CParams get_params() { CParams q = (CParams)__builtin_amdgcn_kernarg_segment_ptr(); asm volatile("" : "+s"(q)); return q; }
struct Ctx { int G, bid, vcu, GX, xcd, lcu, xmode, NGW; };
#define PHASE_IDS() const int tid = launder_i(threadIdx.x), lane = tid & 63, wave = __builtin_amdgcn_readfirstlane(tid >> 6), r32 = lane & 31, hi = lane >> 5; const int gw = C.vcu * 8 + wave; \
    (void)r32; (void)hi; (void)gw; (void)lane; CParams P = get_params(); unsigned char* ws = P->ws

__device__ __forceinline__ void phase_prologue(const Ctx C, unsigned char* lds) {
  PHASE_IDS();
  LAS float* scr = (LAS float*)((LAS unsigned char*)lds + wave * 16384);
  constexpr int I_EVIN = 16 * 104, I_SQ = 16 * 32, I_ODIN = 16 * 45, I_QB = 4 * 48, I_KVB = 2 * 64, PER = I_EVIN + I_SQ + I_ODIN + I_QB + I_KVB + I_SQ;
#pragma unroll 1
  for (int it = gw; it < 2 * PER; it += C.NGW) {
    const int i = it / PER; int r = it - i * PER;
    const float* W; int K, N, kb, nb, row_off = 0; bf16_t* WT;
    if (r < I_EVIN) { W = P->ev_w_in + (size_t)i * 1024 * EV_IN; K = 1024; N = EV_IN; WT = (bf16_t*)(ws + WS_EVIN + i * SZ_EVIN); kb = r / 104; nb = r % 104; }
    else if ((r -= I_EVIN) < I_SQ) { W = P->ev_w_out + (size_t)i * 1024 * 1024; K = 1024; N = 1024; WT = (bf16_t*)(ws + WS_EVOUT + i * SZ_SQ); kb = r / 32; nb = r % 32; }
    else if ((r -= I_SQ) < I_ODIN) { W = P->od_w_in + (size_t)i * 1024 * 1440; K = 1024; N = 1440; WT = (bf16_t*)(ws + WS_ODIN + i * SZ_ODIN); kb = r / 45; nb = r % 45; row_off = nb < 13 ? 0 : 96; }
    else if ((r -= I_ODIN) < I_QB) { W = P->od_w_qb + (size_t)i * 256 * 1536; K = 256; N = 1536; WT = (bf16_t*)(ws + WS_QB + i * SZ_QB); kb = r / 48; nb = r % 48; }
    else if ((r -= I_QB) < I_KVB) { W = P->od_w_kvb + (size_t)i * 128 * 2048; K = 128; N = 2048; WT = (bf16_t*)(ws + WS_KVB + i * SZ_KVB); kb = r / 64; nb = r % 64; }
    else { r -= I_KVB; W = P->od_w_out + (size_t)i * 1024 * 1024; K = 1024; N = 1024; WT = (bf16_t*)(ws + WS_ODOUT + i * SZ_SQ); kb = r / 32; nb = r % 32; }
    transpose_item(W, K, N, WT, kb, nb, row_off, scr, lane);
  }
  const int gt = C.vcu * 512 + tid, NGT = C.G * 512;
  for (int idx = gt; idx < 2 * 12288; idx += NGT) { const int i = idx / 12288, r = idx - i * 12288; *(v4u*)(ws + WS_ODIN + i * SZ_ODIN + (size_t)416 * 1024 * 2 + (size_t)r * 16) = (v4u){0u, 0u, 0u, 0u}; }
  for (int idx = gt; idx < 32768 + 65536 + 1024; idx += NGT) {
    int pos, fi, nf; float theta; float* tc; float* tsn;
    if (idx < 32768) { pos = idx >> 3; fi = idx & 7; nf = 8; theta = 500000.f; tc = (float*)(ws + TAB_A_COS) + idx; tsn = (float*)(ws + TAB_A_SIN) + idx; }
    else if (idx < 32768 + 65536) { const int k = idx - 32768; pos = k >> 4; fi = k & 15; nf = 16; theta = 500000.f; tc = (float*)(ws + TAB_C_COS) + k; tsn = (float*)(ws + TAB_C_SIN) + k; }
    else { const int k = idx - 32768 - 65536; pos = k >> 4; fi = k & 15; nf = 16; theta = 10000.f; tc = (float*)(ws + TAB_X_COS) + k; tsn = (float*)(ws + TAB_X_SIN) + k; }
    const float inv = (float)exp2(-(double)fi / (double)nf * log2((double)theta));
    const float ang = (float)pos * inv;
    double rev = (double)ang * 0.15915494309189535; rev -= floor(rev);
    const float rf = (float)rev;
    *tc = __builtin_amdgcn_cosf(rf); *tsn = __builtin_amdgcn_sinf(rf);
  }
  const float* x = P->x; bf16_t* XB = (bf16_t*)(ws + WS_XB);
#pragma unroll 2
  for (int idx = gt; idx < NT_TOK * DM / 8; idx += NGT) { const f32x4 a = *(const f32x4*)(x + (size_t)idx * 8), b = *(const f32x4*)(x + (size_t)idx * 8 + 4);
    v4u w; w.x = pk2(a[0], a[1]); w.y = pk2(a[2], a[3]); w.z = pk2(b[0], b[1]); w.w = pk2(b[2], b[3]); *(v4u*)(XB + (size_t)idx * 8) = w; }
}

__device__ __forceinline__ void phase_gemm_e1(const Ctx C, unsigned char* lds, int li) {
  CParams P = get_params(); unsigned char* ws = P->ws;
  pg8::Gemm g{(const bf16_t*)(ws + WS_XB), (const bf16_t*)(ws + WS_EVIN + li * SZ_EVIN), NT_TOK, EV_IN, 1024}; pg8::StaticOrder So; So.init(NT_TOK, EV_IN, C.G, C.bid);
  pg8::EpiBf16S E{(bf16_t*)(ws + WS_H), EV_IN, 2304, 1.f, 0};
#ifndef NO_E1
  pg8::gemm_phase<pg8::EpiBf16S, pg8::StaticOrder, true, true>((LAS unsigned char*)lds, g, So, E);
#endif
}
__device__ __forceinline__ void phase_gemm_o1(const Ctx C, unsigned char* lds, int li) {
  CParams P = get_params(); unsigned char* ws = P->ws;
  pg8::Gemm g{(const bf16_t*)(ws + WS_XB), (const bf16_t*)(ws + WS_ODIN + li * SZ_ODIN), NT_TOK, OD_INP, 1024}; pg8::StaticOrder So; So.init(NT_TOK, OD_INP, C.G, C.bid);
  pg8::EpiOddIn E{(float*)(ws + WS_OG), (bf16_t*)(ws + WS_GATE)};
#ifndef NO_O1
  pg8::gemm_phase<pg8::EpiOddIn, pg8::StaticOrder, true, true>((LAS unsigned char*)lds, g, So, E);
#endif
}
__device__ __forceinline__ void phase_gemm_o3(const Ctx C, unsigned char* lds, int li) {
#pragma unroll 1
  for (int which = 0; which < 2; ++which) {
    CParams P = get_params(); unsigned char* ws = P->ws;
    const int N = which ? 2048 : 1536, K = which ? 128 : 256;
    pg8::Gemm g{(const bf16_t*)(ws + (which ? WS_CKVN : WS_CQN)), (const bf16_t*)(ws + (which ? WS_KVB + li * SZ_KVB : WS_QB + li * SZ_QB)), NT_TOK, N, K};
    pg8::StaticOrder So; So.init(NT_TOK, N, C.G, C.bid);
    pg8::EpiBf16S E{(bf16_t*)(ws + (which ? WS_Y : WS_QC)), N, 1 << 30, which ? 1.f : QS_96, 1 << 30};
#ifndef NO_O3
    pg8::gemm_phase<pg8::EpiBf16S, pg8::StaticOrder, true, true>((LAS unsigned char*)lds, g, So, E);
#endif
  }
}
__device__ __forceinline__ void phase_gemm_out(const Ctx C, unsigned char* lds, int layer) {
  CParams P = get_params(); unsigned char* ws = P->ws;
  const bf16_t* Wt = (const bf16_t*)(ws + ((layer & 1) ? WS_ODOUT : WS_EVOUT) + (layer >> 1) * SZ_SQ);
  pg8::Gemm g{(const bf16_t*)(ws + WS_OG), Wt, NT_TOK, 1024, 1024}; pg8::StaticOrder So; So.init(NT_TOK, 1024, C.G, C.bid);
  pg8::EpiF32 E{(float*)(ws + WS_Y), 1024};
#ifndef NO_OUT
  pg8::gemm_phase<pg8::EpiF32, pg8::StaticOrder, true, true>((LAS unsigned char*)lds, g, So, E);
#endif
}

__device__ __forceinline__ void phase_e2(const Ctx C, int li) {
  PHASE_IDS();
  const int grp = (C.vcu * 512 + tid) >> 3, j = tid & 7, NGRP = C.G * 64;
  const float* qn = P->ev_qnorm + li * 64; const float* kn = P->ev_knorm + li * 64;
  bf16_t* H = (bf16_t*)(ws + WS_H);
  const float* tabAc = (const float*)(ws + TAB_A_COS); const float* tabAs = (const float*)(ws + TAB_A_SIN);
  const float* tabXc = (const float*)(ws + TAB_X_COS); const float* tabXs = (const float*)(ws + TAB_X_SIN);
#pragma unroll 1
  for (int it = grp; it < NT_TOK * 26; it += NGRP) {
    const int t = it / 26, ci = it - t * 26, pos = t & (SEQ - 1);
    const int col = ci < 16 ? ci * 64 : (ci < 24 ? 1536 + (ci - 16) * 64 : 2048 + (ci - 24) * 64);
    bf16_t* ptr = H + (size_t)t * EV_IN + col + j * 8;
    float v[8], pr[8]; unpack8(*(const v4u*)ptr, v);
    if (ci < 16) {
#pragma unroll
      for (int k = 0; k < 8; ++k) pr[k] = __shfl_xor(v[k], 1);
      if (j < 2) {
#pragma unroll
        for (int k = 0; k < 8; ++k) { const float c = tabAc[pos * 8 + k], s = tabAs[pos * 8 + k]; v[k] = j == 0 ? v[k] * c - pr[k] * s : v[k] * c + pr[k] * s; }
      }
    } else {
      float ss = 0.f;
#pragma unroll
      for (int k = 0; k < 8; ++k) ss += v[k] * v[k];
      ss += __shfl_xor(ss, 1); ss += __shfl_xor(ss, 2); ss += __shfl_xor(ss, 4);
      const float rinv = 1.0f / sqrtf(ss * (1.0f / 64.0f) + RMS_EPS);
      const float* g = ci < 24 ? qn : kn;
#pragma unroll
      for (int k = 0; k < 8; ++k) v[k] = v[k] * rinv * g[j * 8 + k];
#pragma unroll
      for (int k = 0; k < 8; ++k) pr[k] = __shfl_xor(v[k], 2);
      const int tp = (j < 4) ? (pos >> 6) : (pos & 63), fi = (j & 1) * 8;
#pragma unroll
      for (int k = 0; k < 8; ++k) { const float c = tabXc[tp * 16 + fi + k], s = tabXs[tp * 16 + fi + k]; v[k] = (j & 2) ? v[k] * c + pr[k] * s : v[k] * c - pr[k] * s; }
    }
    if (ci < 8 || (ci >= 16 && ci < 24)) {
#pragma unroll
      for (int k = 0; k < 8; ++k) v[k] *= QS_64;
    }
    *(v4u*)ptr = pack8(v);
  }
}

__device__ __forceinline__ void phase_e3(const Ctx C, unsigned char* lds, int layer) {
  const int li = layer >> 1;
  const float lam_init = layer == 0 ? 0.2f : 0.47071301834305566f;
#pragma unroll 1
  for (int s_ = 0;; ++s_) {
    int u; if (C.xmode) { const int idx = C.lcu + s_ * C.GX; if (idx >= 64) break; u = C.xcd * 64 + idx; } else { u = C.bid + s_ * C.G; if (u >= 512) break; }
    const int bh = u >> 4, qb = u & 15, b = bh >> 2, h = bh & 3;
    const size_t rowb = (size_t)b * SEQ;
    att::f32x16 o[4];
#pragma unroll 1
    for (int c = 0; c < 2; ++c) {
      PHASE_IDS();
      bf16_t* H = (bf16_t*)(ws + WS_H);
      const size_t roww = rowb + qb * 256 + wave * 32;
      att::bf16x8 qr[4];
      { const bf16_t* Qw = H + (roww + r32) * EV_IN + h * 128 + c * 64 + hi * 8;
#pragma unroll
        for (int d0 = 0; d0 < 4; ++d0) qr[d0] = *reinterpret_cast<const att::bf16x8*>(Qw + d0 * 16); }
      att::KVSrc kv{H + rowb * EV_IN + 512 + h * 128 + c * 64, EV_IN, nullptr, 0, H + rowb * EV_IN + 1024 + h * 128, EV_IN};
#ifndef NO_A
      att::attn_body<64, 128>(qr, kv, o, (char*)lds, SEQ);
#endif
      if (c == 0) {
        const int l2 = launder_i(threadIdx.x) & 63;
        float* scrA = (float*)(ws + WS_Y) + ((size_t)C.bid * 8 + wave) * 4096;
#pragma unroll
        for (int r = 0; r < 16; ++r) { float* pr_ = scrA + launder_i(r * 256 + l2);
#pragma unroll
          for (int d0 = 0; d0 < 4; ++d0) pr_[d0 * 64] = o[d0][r]; }
      }
    }
    {
      PHASE_IDS();
      float lam;
      { const float* lp = P->ev_lam + li * 256; const float d1 = wave_sum(lp[lane] * lp[64 + lane]), d2 = wave_sum(lp[128 + lane] * lp[192 + lane]); lam = expf(d1) - expf(d2) + lam_init; }
      const float* subln = P->ev_subln + li * 128;
      const bf16_t* H = (const bf16_t*)(ws + WS_H); bf16_t* OG = (bf16_t*)(ws + WS_OG);
      const float* scrA = (const float*)(ws + WS_Y) + ((size_t)C.bid * 8 + wave) * 4096;
      const size_t roww = rowb + qb * 256 + wave * 32;
      const float post = 1.0f - lam_init;
      float sl[4];
#pragma unroll
      for (int d0 = 0; d0 < 4; ++d0) sl[d0] = subln[d0 * 32 + r32];
#pragma unroll
      for (int r = 0; r < 16; ++r) {
        const float* pr_ = scrA + launder_i(r * 256 + lane);
        float ss = 0.f;
#pragma unroll
        for (int d0 = 0; d0 < 4; ++d0) { const float dlt = pr_[d0 * 64] - lam * o[d0][r]; o[d0][r] = dlt; ss += dlt * dlt; }
        ss += __shfl_xor(ss, 1); ss += __shfl_xor(ss, 2); ss += __shfl_xor(ss, 4); ss += __shfl_xor(ss, 8); ss += __shfl_xor(ss, 16);
        const float rinv = post / sqrtf(ss * (1.0f / 128.0f) + RMS_EPS);
        const size_t row = roww + launder_i(att::crow(r, hi));
        const bf16_t* gp = H + row * EV_IN + 2304 + h * 128 + r32; bf16_t* op = OG + row * 1024 + h * 128 + r32;
#pragma unroll
        for (int d0 = 0; d0 < 4; ++d0) op[d0 * 32] = att::f2bf(o[d0][r] * rinv * sl[d0] * att::bf2f(gp[d0 * 32]));
      }
    }
  }
#pragma unroll 1
  for (int s_ = 0;; ++s_) {
    int u; if (C.xmode) { const int idx = C.lcu + s_ * C.GX; if (idx >= 128) break; u = C.xcd * 128 + idx; } else { u = C.bid + s_ * C.G; if (u >= 1024) break; }
    const int bh = u >> 4, qb = u & 15, b = bh >> 3, hq = bh & 7, kvh = hq >> 2;
    const size_t rowb = (size_t)b * SEQ;
    att::f32x16 o[2];
    {
      PHASE_IDS();
      bf16_t* H = (bf16_t*)(ws + WS_H);
      const size_t roww = rowb + qb * 256 + wave * 32;
      att::bf16x8 qr[4];
      { const bf16_t* Qw = H + (roww + r32) * EV_IN + 1536 + hq * 64 + hi * 8;
#pragma unroll
        for (int d0 = 0; d0 < 4; ++d0) qr[d0] = *reinterpret_cast<const att::bf16x8*>(Qw + d0 * 16); }
      att::KVSrc kv{H + rowb * EV_IN + 2048 + kvh * 64, EV_IN, nullptr, 0, H + rowb * EV_IN + 2176 + kvh * 64, EV_IN};
#ifndef NO_B
      att::attn_body<64, 64>(qr, kv, o, (char*)lds, SEQ);
#endif
    }
    {
      PHASE_IDS();
      const bf16_t* H = (const bf16_t*)(ws + WS_H); bf16_t* OG = (bf16_t*)(ws + WS_OG);
      const size_t roww = rowb + qb * 256 + wave * 32;
#pragma unroll
      for (int r = 0; r < 16; ++r) { const size_t row = roww + launder_i(att::crow(r, hi));
        const bf16_t* gp = H + row * EV_IN + 2816 + hq * 64 + r32; bf16_t* op = OG + row * 1024 + 512 + hq * 64 + r32;
#pragma unroll
        for (int d0 = 0; d0 < 2; ++d0) op[d0 * 32] = att::f2bf(o[d0][r] * att::bf2f(gp[d0 * 32])); }
    }
  }
}

__device__ __forceinline__ void phase_o2(const Ctx C, int li) {
  PHASE_IDS();
  const float* qn = P->od_qnorm + li * 256; const float* kvn = P->od_kvnorm + li * 128;
  const float* HF = (const float*)(ws + WS_OG); bf16_t* CQN = (bf16_t*)(ws + WS_CQN); bf16_t* CKVN = (bf16_t*)(ws + WS_CKVN); bf16_t* KRR = (bf16_t*)(ws + WS_KRR);
  const float* tabCc = (const float*)(ws + TAB_C_COS); const float* tabCs = (const float*)(ws + TAB_C_SIN);
  const f32x4 gq = *(const f32x4*)(qn + 4 * lane); const f32x2 gk = *(const f32x2*)(kvn + 2 * lane);
#pragma unroll 2
  for (int t = gw; t < NT_TOK; t += C.NGW) {
    const float* hr = HF + (size_t)t * 512; const int pos = t & (SEQ - 1);
    const f32x4 a = *(const f32x4*)(hr + 4 * lane); const f32x2 c2 = *(const f32x2*)(hr + 256 + 2 * lane);
    const float sa = wave_sum((a[0] * a[0] + a[1] * a[1]) + (a[2] * a[2] + a[3] * a[3])), sc = wave_sum(c2[0] * c2[0] + c2[1] * c2[1]);
    const float ra = 1.0f / sqrtf(sa * (1.0f / 256.0f) + RMS_EPS), rc = 1.0f / sqrtf(sc * (1.0f / 128.0f) + RMS_EPS);
    v2u wq; wq.x = pk2(a[0] * ra * gq[0], a[1] * ra * gq[1]); wq.y = pk2(a[2] * ra * gq[2], a[3] * ra * gq[3]);
    *(v2u*)(CQN + (size_t)t * 256 + 4 * lane) = wq;
    *(unsigned*)(CKVN + (size_t)t * 128 + 2 * lane) = pk2(c2[0] * rc * gk[0], c2[1] * rc * gk[1]);
    if (lane < 16) { const float x1 = hr[384 + lane], x2 = hr[400 + lane], cs = tabCc[pos * 16 + lane], sn = tabCs[pos * 16 + lane];
      KRR[(size_t)t * 32 + lane] = (bf16_t)f2bf_rne(x1 * cs - x2 * sn); KRR[(size_t)t * 32 + 16 + lane] = (bf16_t)f2bf_rne(x2 * cs + x1 * sn); }
  }
}

__device__ __forceinline__ void phase_o4(const Ctx C, unsigned char* lds) {
#pragma unroll 1
  for (int s_ = 0;; ++s_) {
    int u; if (C.xmode) { const int idx = C.lcu + s_ * C.GX; if (idx >= 256) break; u = C.xcd * 256 + idx; } else { u = C.bid + s_ * C.G; if (u >= 2048) break; }
    const int bh = u >> 4, qb = u & 15, b = bh >> 4, h = bh & 15;
    const size_t rowb = (size_t)b * SEQ;
    att::f32x16 o[2];
    {
      PHASE_IDS();
      const bf16_t* QC = (const bf16_t*)(ws + WS_QC); const bf16_t* KVC = (const bf16_t*)(ws + WS_Y); const bf16_t* KRR = (const bf16_t*)(ws + WS_KRR);
      const float* tabCc = (const float*)(ws + TAB_C_COS); const float* tabCs = (const float*)(ws + TAB_C_SIN);
      const size_t roww = rowb + qb * 256 + wave * 32;
      att::bf16x8 qr[6];
      { const bf16_t* Qw = QC + (roww + r32) * 1536 + h * 96 + hi * 8;
#pragma unroll
        for (int d0 = 0; d0 < 6; ++d0) qr[d0] = *reinterpret_cast<const att::bf16x8*>(Qw + d0 * 16);
        const int pos = qb * 256 + wave * 32 + r32;
        float x1[8], x2[8]; unpack8(__builtin_bit_cast(v4u, qr[4]), x1); unpack8(__builtin_bit_cast(v4u, qr[5]), x2);
        float y1[8], y2[8];
#pragma unroll
        for (int k = 0; k < 8; ++k) { const float cs = tabCc[pos * 16 + 8 * hi + k], sn = tabCs[pos * 16 + 8 * hi + k]; y1[k] = x1[k] * cs - x2[k] * sn; y2[k] = x2[k] * cs + x1[k] * sn; }
        qr[4] = __builtin_bit_cast(att::bf16x8, pack8(y1)); qr[5] = __builtin_bit_cast(att::bf16x8, pack8(y2)); }
      att::KVSrc kv{KVC + rowb * 2048 + h * 128, 2048, KRR + rowb * 32, 32, KVC + rowb * 2048 + h * 128 + 64, 2048};
#ifndef NO_C
      att::attn_body<96, 64>(qr, kv, o, (char*)lds, SEQ);
#endif
    }
    {
      PHASE_IDS();
      const bf16_t* GATE = (const bf16_t*)(ws + WS_GATE); bf16_t* OG = (bf16_t*)(ws + WS_OG);
      const size_t roww = rowb + qb * 256 + wave * 32;
#pragma unroll
      for (int r = 0; r < 16; ++r) { const size_t row = roww + launder_i(att::crow(r, hi));
        const bf16_t* gp = GATE + row * 1024 + h * 64 + r32; bf16_t* op = OG + row * 1024 + h * 64 + r32;
#pragma unroll
        for (int d0 = 0; d0 < 2; ++d0) op[d0 * 32] = att::f2bf(o[d0][r] * att::bf2f(gp[d0 * 32])); }
    }
  }
}

__device__ __forceinline__ void phase_ln(const Ctx C, int layer) {
  PHASE_IDS();
  const int li = layer >> 1;
  const float* lg = ((layer & 1) ? P->od_ln_g : P->ev_ln_g) + li * 1024; const float* lb = ((layer & 1) ? P->od_ln_b : P->ev_ln_b) + li * 1024;
  const float* xin = layer == 0 ? P->x : P->out; float* out = P->out;
  const float* Y = (const float*)(ws + WS_Y); bf16_t* XB = (bf16_t*)(ws + WS_XB);
#pragma unroll 1
  for (int t = gw; t < NT_TOK; t += C.NGW) {
    const f32x4* xr = (const f32x4*)(xin + (size_t)t * 1024) + lane; const f32x4* yr = (const f32x4*)(Y + (size_t)t * 1024) + lane;
    f32x4 v[4]; float s = 0.f;
#pragma unroll
    for (int k = 0; k < 4; ++k) { v[k] = xr[64 * k] * ALPHA + yr[64 * k]; s += (v[k][0] + v[k][1]) + (v[k][2] + v[k][3]); }
    const float mean = wave_sum(s) * (1.0f / 1024.0f); float s2 = 0.f;
#pragma unroll
    for (int k = 0; k < 4; ++k) { v[k] = v[k] - mean; s2 += (v[k][0] * v[k][0] + v[k][1] * v[k][1]) + (v[k][2] * v[k][2] + v[k][3] * v[k][3]); }
    const float rstd = 1.0f / sqrtf(wave_sum(s2) * (1.0f / 1024.0f) + LN_EPS);
    f32x4* orow = (f32x4*)(out + (size_t)t * 1024) + lane; v2u* brow = (v2u*)(XB + (size_t)t * 1024) + lane;
#pragma unroll
    for (int k = 0; k < 4; ++k) { const f32x4 gg = *((const f32x4*)lg + lane + 64 * k), bb = *((const f32x4*)lb + lane + 64 * k);
      const f32x4 r = v[k] * rstd * gg + bb; orow[64 * k] = r; v2u w; w.x = pk2(r[0], r[1]); w.y = pk2(r[2], r[3]); brow[64 * k] = w; }
  }
}

__global__ void __launch_bounds__(512, 2) fwd_kernel(Params p_unused) {
  extern __shared__ __attribute__((aligned(16))) unsigned char lds[];
  cg::grid_group grid = cg::this_grid();
  Ctx C;
  C.G = gridDim.x; C.bid = blockIdx.x;
  C.xmode = ((C.G % 8 == 0) && (C.G >= 8)) ? 1 : 0;
  C.vcu = C.xmode ? (C.bid % 8) * (C.G / 8) + C.bid / 8 : C.bid;
  C.GX = C.xmode ? C.G / 8 : C.G; C.xcd = C.xmode ? C.vcu / C.GX : 0; C.lcu = C.xmode ? C.vcu % C.GX : 0;
  C.NGW = C.G * 8;
  if (threadIdx.x < 8) ((LAS unsigned*)((LAS unsigned char*)lds + 131072))[threadIdx.x] = 0u;
  __syncthreads();
  XcdBarrier bar = xcd_barrier_post((unsigned*)(get_params()->ws + WS_BAR), (volatile LAS unsigned*)((LAS unsigned char*)lds + 131072));
  phase_prologue(C, lds);
  grid.sync();
#pragma unroll 1
  for (int layer = 0; layer < 4; ++layer) {
    const int li = layer >> 1;
    if ((layer & 1) == 0) {
#ifdef REP_GEMM
      for (int rep_ = 0; rep_ < REP_GEMM; ++rep_)
#endif
      phase_gemm_e1(C, lds, li);
      GSYNC();
      phase_e2(C, li); GSYNC();
#ifdef REP_ATT
      for (int rep_ = 0; rep_ < REP_ATT; ++rep_)
#endif
      phase_e3(C, lds, layer);
    } else {
#ifdef REP_GEMM
      for (int rep_ = 0; rep_ < REP_GEMM; ++rep_)
#endif
      phase_gemm_o1(C, lds, li);
      GSYNC();
      phase_o2(C, li); GSYNC();
#ifdef REP_GEMM
      for (int rep_ = 0; rep_ < REP_GEMM; ++rep_)
#endif
      phase_gemm_o3(C, lds, li);
      GSYNC();
#ifdef REP_ATT
      for (int rep_ = 0; rep_ < REP_ATT; ++rep_)
#endif
      phase_o4(C, lds);
    }
    GSYNC();
#ifdef REP_GEMM
    for (int rep_ = 0; rep_ < REP_GEMM; ++rep_)
#endif
    phase_gemm_out(C, lds, layer);
    GSYNC();
    phase_ln(C, layer);
    if (layer < 3) GSYNC();
  }
}

extern "C" void kernel_launch(void* const* d_in, const int* in_sizes, int n_in, void* d_out, int out_size, void* d_ws, size_t ws_size, hipStream_t stream) {
  static int grid_blocks = 0;
  if (grid_blocks == 0) {
    if (n_in != 17 || in_sizes[0] != NT_TOK * DM || out_size != NT_TOK * DM || ws_size < WS_END) {
      fprintf(stderr, "kernel_launch: unexpected shapes: n_in %d in0 %d out %d ws %zu (need >= %zu)\n", n_in, n_in > 0 ? in_sizes[0] : -1, out_size, ws_size, (size_t)WS_END); grid_blocks = -1; return; }
    int dev = 0, cus = 0, per_cu = 0;
    hipGetDevice(&dev); hipDeviceGetAttribute(&cus, hipDeviceAttributeMultiprocessorCount, dev);
    if (hipFuncSetAttribute((const void*)fwd_kernel, hipFuncAttributeMaxDynamicSharedMemorySize, LDS_BYTES) != hipSuccess) { fprintf(stderr, "kernel_launch: hipFuncSetAttribute failed\n"); grid_blocks = -1; return; }
    if (hipOccupancyMaxActiveBlocksPerMultiprocessor(&per_cu, (const void*)fwd_kernel, 512, LDS_BYTES) != hipSuccess || per_cu < 1) { fprintf(stderr, "kernel_launch: occupancy query gave %d\n", per_cu); per_cu = 1; }
    (void)hipGetLastError();
    grid_blocks = cus * 1;
  }
  if (grid_blocks < 0) return;
  Params p{};
  p.x = (const float*)d_in[0]; p.ev_w_in = (const float*)d_in[1]; p.ev_w_out = (const float*)d_in[2]; p.ev_lam = (const float*)d_in[3]; p.ev_subln = (const float*)d_in[4];
  p.ev_qnorm = (const float*)d_in[5]; p.ev_knorm = (const float*)d_in[6]; p.ev_ln_g = (const float*)d_in[7]; p.ev_ln_b = (const float*)d_in[8]; p.od_w_in = (const float*)d_in[9];
  p.od_qnorm = (const float*)d_in[10]; p.od_kvnorm = (const float*)d_in[11]; p.od_w_qb = (const float*)d_in[12]; p.od_w_kvb = (const float*)d_in[13]; p.od_w_out = (const float*)d_in[14];
  p.od_ln_g = (const float*)d_in[15]; p.od_ln_b = (const float*)d_in[16]; p.out = (float*)d_out; p.ws = (unsigned char*)d_ws;
  if (hipMemsetAsync((char*)d_ws + WS_BAR, 0, WS_BAR_BYTES, stream) != hipSuccess) { fprintf(stderr, "kernel_launch: memset of the barrier words failed\n"); return; }
  void* args[] = {&p};
  hipError_t e = hipLaunchCooperativeKernel((const void*)fwd_kernel, dim3(grid_blocks), dim3(512), args, LDS_BYTES, stream);
  if (e != hipSuccess) fprintf(stderr, "kernel_launch: cooperative launch failed: %s (grid %d)\n", hipGetErrorString(e), grid_blocks);
}
```

```cpp
#include <hip/hip_runtime.h>
#include <hip/hip_cooperative_groups.h>
#include <cstdio>
#include <cstdint>
namespace cg = cooperative_groups;
__device__ __forceinline__ int launder_i(int v) { asm volatile("" : "+v"(v)); return v; }
namespace pg8 {
#define PG8_LAS __attribute__((address_space(3)))
typedef unsigned short bf16_t;
typedef short bf16x8 __attribute__((ext_vector_type(8)));
typedef float f32x4 __attribute__((ext_vector_type(4)));
typedef unsigned u32x4 __attribute__((ext_vector_type(4)));
constexpr int BM = 256, BK = 64, HALF = 128, HTB = HALF * BK * 2  , STAGE_BYTES = 8 * HTB, NXCD = 8, WGM = 8;

__host__ __device__ __forceinline__ int lds_byte(int r, int c) { const int st = (r >> 4) * 2 + (c >> 5), rr = r & 15, cc = c & 31, ob = rr * 64 + cc * 2; return st * 1024 + (ob ^ (((ob >> 9) & 1) << 5)); }
__host__ __device__ __forceinline__ void stage_rc(int b, int& R, int& C) { const int st = b / 1024, sb = b % 1024, swz = sb ^ (((sb >> 9) & 1) << 5); R = (st >> 1) * 16 + swz / 64; C = (st & 1) * 32 + (swz % 64) / 2; }
__host__ __device__ __forceinline__ int perm32(int rho) { const int n = rho >> 4, i = rho & 15; return 8 * (i >> 2) + 4 * n + (i & 3); }

struct Unit { int pm, pn; };
struct Gemm { const bf16_t* A; const bf16_t* Bt; int M, N, K; };

struct StaticOrder {
    int nM, nN, nwg, G, c;
    __host__ __device__ void init(int M, int N, int G_, int c_) { nM = M / BM; nN = N / BM; nwg = nM * nN; G = G_; c = c_; }
    __host__ __device__ bool next(int i, Unit& u) const {
        const long L = (long)i * G + c; if (L >= nwg) return false;
        int wgid = (int)L; { const int q = nwg / NXCD, r = nwg % NXCD, xcd = wgid % NXCD, off = wgid / NXCD; wgid = (xcd < r ? xcd * (q + 1) : r * (q + 1) + (xcd - r) * q) + off; }
        const int nig = WGM * nN, gid = wgid / nig, fm = gid * WGM, gsz = (nM - fm) < WGM ? (nM - fm) : WGM;
        u.pm = fm + ((wgid % nig) % gsz); u.pn = (wgid % nig) / gsz; return true;
    }
    __device__ __forceinline__ void a_ready(const Unit&) const {}
    __device__ __forceinline__ void done(const Unit&) const {}
};

__device__ __forceinline__ unsigned cvt_pk_bf16(float lo, float hi) { unsigned r; asm volatile("v_cvt_pk_bf16_f32 %0, %1, %2" : "=v"(r) : "v"(lo), "v"(hi)); return r; }
__device__ __forceinline__ float silu_f(float v) { return v * __builtin_amdgcn_rcpf(1.0f + __builtin_amdgcn_exp2f(-1.4426950408889634f * v)); }
__device__ __forceinline__ f32x4 silu4(f32x4 v) { return (f32x4){silu_f(v[0]), silu_f(v[1]), silu_f(v[2]), silu_f(v[3])}; }

struct EpiBf16S {
    static constexpr bool PERM = true, AFTER_DRAIN = false;
    bf16_t* O; int ldc; int silu_from; float scale; int scale_until;
    __device__ __forceinline__ void operator()(const f32x4 (&acc)[2][2][4][2], const Unit& u, int wr, int wc, int fr, int fq) const {
        const int row0 = u.pm * BM + wr * 64 + fr; const int colt = u.pn * BM;
        const bool act = colt >= silu_from; const float sc = colt < scale_until ? scale : 1.f;
        const int col0 = colt + wc * 32 + 8 * fq;
#pragma unroll
        for (int ai = 0; ai < 2; ++ai)
#pragma unroll
            for (int m = 0; m < 4; ++m) { bf16_t* rowp = O + (size_t)(row0 + ai * HALF + m * 16) * ldc + col0;
#pragma unroll
                for (int bj = 0; bj < 2; ++bj) { f32x4 v0 = acc[ai][bj][m][0], v1 = acc[ai][bj][m][1];
                    if (act) { v0 = silu4(v0); v1 = silu4(v1); }
                    v0 = v0 * sc; v1 = v1 * sc; u32x4 w; w.x = cvt_pk_bf16(v0[0], v0[1]); w.y = cvt_pk_bf16(v0[2], v0[3]); w.z = cvt_pk_bf16(v1[0], v1[1]); w.w = cvt_pk_bf16(v1[2], v1[3]);
                    *(u32x4*)(rowp + bj * HALF) = w; } }
    }
};
struct EpiOddIn {
    static constexpr bool PERM = true, AFTER_DRAIN = false;
    float* HF; bf16_t* G;
    __device__ __forceinline__ void operator()(const f32x4 (&acc)[2][2][4][2], const Unit& u, int wr, int wc, int fr, int fq) const {
        const int row0 = u.pm * BM + wr * 64 + fr; const int colt = u.pn * BM;
        const int col0 = colt + wc * 32 + 8 * fq;
        if (colt < 512) {
#pragma unroll
            for (int ai = 0; ai < 2; ++ai)
#pragma unroll
                for (int m = 0; m < 4; ++m) { float* rowp = HF + (size_t)(row0 + ai * HALF + m * 16) * 512 + col0;
#pragma unroll
                    for (int bj = 0; bj < 2; ++bj) { *(f32x4*)(rowp + bj * HALF) = acc[ai][bj][m][0]; *(f32x4*)(rowp + bj * HALF + 4) = acc[ai][bj][m][1]; } }
        } else {
#pragma unroll
            for (int ai = 0; ai < 2; ++ai)
#pragma unroll
                for (int m = 0; m < 4; ++m) { bf16_t* rowp = G + (size_t)(row0 + ai * HALF + m * 16) * 1024 + (col0 - 512);
#pragma unroll
                    for (int bj = 0; bj < 2; ++bj) { const f32x4 v0 = silu4(acc[ai][bj][m][0]), v1 = silu4(acc[ai][bj][m][1]);
                        u32x4 w; w.x = cvt_pk_bf16(v0[0], v0[1]); w.y = cvt_pk_bf16(v0[2], v0[3]); w.z = cvt_pk_bf16(v1[0], v1[1]); w.w = cvt_pk_bf16(v1[2], v1[3]);
                        *(u32x4*)(rowp + bj * HALF) = w; } }
        }
    }
};
struct EpiF32 {
    static constexpr bool PERM = false, AFTER_DRAIN = false;
    float* Y; int ldc;
    __device__ __forceinline__ void operator()(const f32x4 (&acc)[2][2][4][2], const Unit& u, int wr, int wc, int fr, int fq) const {
        const int row0 = u.pm * BM + wr * 64 + fr; const int col0 = u.pn * BM + wc * 32 + 4 * fq;
#pragma unroll
        for (int ai = 0; ai < 2; ++ai)
#pragma unroll
            for (int m = 0; m < 4; ++m) { float* rowp = Y + (size_t)(row0 + ai * HALF + m * 16) * ldc + col0;
#pragma unroll
                for (int bj = 0; bj < 2; ++bj)
#pragma unroll
                    for (int n = 0; n < 2; ++n) *(f32x4*)(rowp + bj * HALF + n * 16) = acc[ai][bj][m][n]; }
    }
};

template <class Epi, class Sched, bool ALIGN_EPI = false, bool SP2 = false>
__device__ __forceinline__ void gemm_phase(PG8_LAS unsigned char* lds, const Gemm g, const Sched& S, const Epi& E) {
    const int tid = launder_i(threadIdx.x), wid = __builtin_amdgcn_readfirstlane(tid >> 6), lane = tid & 63, wr = wid >> 2, wc = wid & 3, fr = lane & 15, fq = lane >> 4;
    const int K = g.K, nt = K / BK;
    unsigned voffA[2], voffB[2];
#pragma unroll
    for (int i = 0; i < 2; ++i) { int R, C; stage_rc(tid * 16 + i * 8192, R, C); const int Rb = Epi::PERM ? ((R & ~31) + perm32(R & 31)) : R;
        voffA[i] = (unsigned)(R * K + C) * 2u; voffB[i] = (unsigned)(Rb * K + C) * 2u; }
    const size_t kstep = (size_t)(BK * 2);
    const size_t hstep = (size_t)HALF * K * 2;
    const size_t tstep = 2 * hstep;
    const unsigned ldsw = (unsigned)wid * 1024u;
    const int aoff = lds_byte(wr * 64 + fr, fq * 8), boff = lds_byte(wc * 32 + fr, fq * 8);
#define PG8_SA(b, h) (((b) * 2 + (h)) * HTB)
#define PG8_SB(b, h) ((4 + (b) * 2 + (h)) * HTB)
#define PG8_STAGE(bufoff, gbase, voff) do { _Pragma("unroll") for (int _i = 0; _i < 2; ++_i) \
        __builtin_amdgcn_global_load_lds((const unsigned*)((const char*)(gbase) + (voff)[_i]), (PG8_LAS unsigned*)(lds + (bufoff) + ldsw + _i * 8192), 16, 0, 0); } while (0)
#define PG8_LDA(dst, b, h) do { _Pragma("unroll") for (int m = 0; m < 4; ++m) _Pragma("unroll") for (int k = 0; k < 2; ++k) dst[m][k] = *(const PG8_LAS bf16x8*)(lds + PG8_SA(b, h) + aoff + m * 2048 + k * 1024); } while (0)
#define PG8_LDB(dst, b, h) do { _Pragma("unroll") for (int n = 0; n < 2; ++n) _Pragma("unroll") for (int k = 0; k < 2; ++k) dst[n][k] = *(const PG8_LAS bf16x8*)(lds + PG8_SB(b, h) + boff + n * 2048 + k * 1024); } while (0)
#define PG8_MMA(ai, bj, At, Bt) do { __builtin_amdgcn_s_setprio(1); _Pragma("unroll") for (int m = 0; m < 4; ++m) _Pragma("unroll") for (int n = 0; n < 2; ++n) _Pragma("unroll") for (int k = 0; k < 2; ++k) \
        acc[ai][bj][m][n] = __builtin_amdgcn_mfma_f32_16x16x32_bf16(Bt[n][k], At[m][k], acc[ai][bj][m][n], 0, 0, 0); __builtin_amdgcn_s_setprio(0); } while (0)
#define PG8_WAIT_V(n) asm volatile("s_waitcnt vmcnt(" #n ")" ::: "memory")
#define PG8_WAIT_L(n) asm volatile("s_waitcnt lgkmcnt(" #n ")" ::: "memory")
#define PG8_BAR __builtin_amdgcn_s_barrier()
#define PG8_SCHED __builtin_amdgcn_sched_barrier(0)
    Unit cur, nxt; int ui = 0;
    if (!S.next(0, cur)) return;
    f32x4 acc[2][2][4][2];
#pragma unroll
    for (int a = 0; a < 2; ++a)
#pragma unroll
        for (int b = 0; b < 2; ++b)
#pragma unroll
            for (int m = 0; m < 4; ++m)
#pragma unroll
                for (int n = 0; n < 2; ++n) acc[a][b][m][n] = (f32x4){0.f, 0.f, 0.f, 0.f};
    bf16x8 At[4][2], B0[2][2], B1[2][2];
    const char* cA = (const char*)g.A + (size_t)cur.pm * tstep; const char* cB = (const char*)g.Bt + (size_t)cur.pn * tstep;
    S.a_ready(cur);
    if constexpr (SP2) {
        PG8_STAGE(PG8_SB(0, 0), cB, voffB); PG8_STAGE(PG8_SB(0, 1), cB + hstep, voffB); PG8_STAGE(PG8_SA(0, 0), cA, voffA); PG8_STAGE(PG8_SA(0, 1), cA + hstep, voffA);
        if (wr == 1) PG8_BAR;
        PG8_WAIT_V(2); PG8_BAR;
        PG8_STAGE(PG8_SB(1, 0), cB + kstep, voffB); PG8_STAGE(PG8_SA(1, 0), cA + kstep, voffA); PG8_STAGE(PG8_SB(1, 1), cB + hstep + kstep, voffB);
        PG8_WAIT_V(6); PG8_BAR;
    } else {
        PG8_STAGE(PG8_SB(0, 0), cB, voffB); PG8_STAGE(PG8_SA(0, 0), cA, voffA); PG8_STAGE(PG8_SB(0, 1), cB + hstep, voffB); PG8_STAGE(PG8_SA(0, 1), cA + hstep, voffA);
        if (wr == 1) PG8_BAR;
        PG8_WAIT_V(4); PG8_BAR;
        PG8_STAGE(PG8_SB(1, 0), cB + kstep, voffB); PG8_STAGE(PG8_SA(1, 0), cA + kstep, voffA); PG8_STAGE(PG8_SB(1, 1), cB + hstep + kstep, voffB);
        PG8_WAIT_V(6); PG8_BAR;
    }
    for (;;) {
        const bool has_next = S.next(ui + 1, nxt);
        const char* nA = has_next ? (const char*)g.A + (size_t)nxt.pm * tstep : cA; const char* nB = has_next ? (const char*)g.Bt + (size_t)nxt.pn * tstep : cB;
        for (int t = 0; t < nt; t += 2) {
            const bool last = (t == nt - 2);
            const char* a1 = cA + (size_t)(t + 1) * kstep;
            const char* a2 = last ? nA : cA + (size_t)(t + 2) * kstep; const char* b2 = last ? nB : cB + (size_t)(t + 2) * kstep;
            const char* a3 = a2 + kstep; const char* b3 = b2 + kstep;
            if (last && has_next) S.a_ready(nxt);
            if constexpr (SP2) {
            PG8_LDB(B0, 0, 0); PG8_LDB(B1, 0, 1); PG8_SCHED; PG8_LDA(At, 0, 0); PG8_STAGE(PG8_SA(1, 1), a1 + hstep, voffA);
            PG8_WAIT_V(8); PG8_WAIT_L(0); PG8_BAR; PG8_MMA(0, 0, At, B0); PG8_MMA(0, 1, At, B1); PG8_BAR; PG8_SCHED;
            PG8_LDA(At, 0, 1); PG8_STAGE(PG8_SB(0, 0), b2, voffB); PG8_STAGE(PG8_SB(0, 1), b2 + hstep, voffB); PG8_STAGE(PG8_SA(0, 0), a2, voffA);
            PG8_WAIT_V(8); PG8_WAIT_L(0); PG8_BAR; PG8_MMA(1, 0, At, B0); PG8_MMA(1, 1, At, B1); PG8_BAR; PG8_SCHED;
            PG8_LDB(B0, 1, 0); PG8_LDB(B1, 1, 1); PG8_SCHED; PG8_LDA(At, 1, 0); PG8_STAGE(PG8_SA(0, 1), a2 + hstep, voffA);
            PG8_WAIT_V(8); PG8_WAIT_L(0); PG8_BAR; PG8_MMA(0, 0, At, B0); PG8_MMA(0, 1, At, B1); PG8_BAR; PG8_SCHED;
            PG8_LDA(At, 1, 1); PG8_STAGE(PG8_SB(1, 0), b3, voffB); PG8_STAGE(PG8_SB(1, 1), b3 + hstep, voffB); PG8_STAGE(PG8_SA(1, 0), a3, voffA);
            PG8_WAIT_V(8); PG8_WAIT_L(0); PG8_BAR; PG8_MMA(1, 0, At, B0); PG8_MMA(1, 1, At, B1); PG8_BAR; PG8_SCHED;
            } else {
            PG8_LDB(B0, 0, 0); PG8_SCHED; PG8_LDA(At, 0, 0); PG8_STAGE(PG8_SA(1, 1), a1 + hstep, voffA);
            PG8_WAIT_L(8); PG8_BAR; PG8_WAIT_L(0); PG8_MMA(0, 0, At, B0); PG8_BAR; PG8_SCHED;
            PG8_LDB(B1, 0, 1); PG8_STAGE(PG8_SB(0, 0), b2, voffB);
            PG8_BAR; PG8_WAIT_L(0); PG8_MMA(0, 1, At, B1); PG8_BAR;
            PG8_LDA(At, 0, 1); PG8_STAGE(PG8_SA(0, 0), a2, voffA);
            PG8_BAR; PG8_WAIT_L(0); PG8_MMA(1, 0, At, B0); PG8_BAR; PG8_SCHED;
            PG8_STAGE(PG8_SB(0, 1), b2 + hstep, voffB);
            PG8_WAIT_V(6); PG8_BAR; PG8_MMA(1, 1, At, B1); PG8_BAR;
            PG8_LDB(B0, 1, 0); PG8_SCHED; PG8_LDA(At, 1, 0); PG8_STAGE(PG8_SA(0, 1), a2 + hstep, voffA);
            PG8_WAIT_L(8); PG8_BAR; PG8_WAIT_L(0); PG8_MMA(0, 0, At, B0); PG8_BAR; PG8_SCHED;
            PG8_LDB(B1, 1, 1); PG8_STAGE(PG8_SB(1, 0), b3, voffB);
            PG8_BAR; PG8_WAIT_L(0); PG8_MMA(0, 1, At, B1); PG8_BAR;
            PG8_LDA(At, 1, 1); PG8_STAGE(PG8_SA(1, 0), a3, voffA);
            PG8_BAR; PG8_WAIT_L(0); PG8_MMA(1, 0, At, B0); PG8_BAR; PG8_SCHED;
            PG8_STAGE(PG8_SB(1, 1), b3 + hstep, voffB);
            PG8_WAIT_V(6); PG8_BAR; PG8_MMA(1, 1, At, B1); PG8_BAR;
            }
        }
        if constexpr (ALIGN_EPI) { if (wr == 0) PG8_BAR; }
        if constexpr (!Epi::AFTER_DRAIN) { E(acc, cur, wr, wc, fr, fq); S.done(cur); }
        if (!has_next) break;
#pragma unroll
        for (int a = 0; a < 2; ++a)
#pragma unroll
            for (int b = 0; b < 2; ++b)
#pragma unroll
                for (int m = 0; m < 4; ++m)
#pragma unroll
                    for (int n = 0; n < 2; ++n) acc[a][b][m][n] = (f32x4){0.f, 0.f, 0.f, 0.f};
        cur = nxt; cA = nA; cB = nB; ++ui;
        if constexpr (ALIGN_EPI) { if (wr == 1) PG8_BAR; }
    }
    PG8_WAIT_V(0);
    if constexpr (!ALIGN_EPI) { if (wr == 0) PG8_BAR; }
    PG8_BAR;
    if constexpr (Epi::AFTER_DRAIN) { E.fused(acc, cur, wr, wc, fr, fq, lds, wid, lane); S.done(cur); }
#undef PG8_SA
#undef PG8_SB
#undef PG8_STAGE
#undef PG8_LDA
#undef PG8_LDB
#undef PG8_MMA
#undef PG8_WAIT_V
#undef PG8_WAIT_L
#undef PG8_BAR
#undef PG8_SCHED
}
}

namespace att {
typedef unsigned short bf16_t;
using bf16x8 = __attribute__((ext_vector_type(8))) short;
using s16x4  = __attribute__((ext_vector_type(4))) short;
using f32x16 = __attribute__((ext_vector_type(16))) float;
using u32x4  = __attribute__((ext_vector_type(4))) unsigned;
#define SBAR() __builtin_amdgcn_sched_barrier(0)
constexpr float THR = 8.f;
__device__ __forceinline__ int crow(int r, int hi) { return (r & 3) + 8 * (r >> 2) + 4 * hi; }
typedef float f32x2_t __attribute__((ext_vector_type(2))); typedef __bf16 bf16x2_t __attribute__((ext_vector_type(2)));
__device__ __forceinline__ unsigned cvtpk(float lo, float hi) { f32x2_t v = {lo, hi}; bf16x2_t b = __builtin_convertvector(v, bf16x2_t); return __builtin_bit_cast(unsigned, b); }
__device__ __forceinline__ float bf2f(bf16_t h) { return __uint_as_float(((unsigned)h) << 16); }
__device__ __forceinline__ bf16_t f2bf(float f) { return (bf16_t)(cvtpk(f, 0.f) & 0xffffu); }

__device__ __forceinline__ float fsub_s(float a, float b) { float r; asm("v_sub_f32_e32 %0, %1, %2" : "=v"(r) : "v"(a), "v"(b)); return r; }
__device__ __forceinline__ void partialSM(f32x16& p0, f32x16& p1, float& m_reg, float& mn, float& alpha) {
  float a = fmaxf(fmaxf(p0[0], p0[1]), p1[0]), b = fmaxf(fmaxf(p0[2], p0[3]), p1[1]); a = fmaxf(fmaxf(a, p1[2]), p1[3]);
#pragma unroll
  for (int r = 4; r < 16; r += 4) { a = fmaxf(fmaxf(a, p0[r]), p0[r + 1]); b = fmaxf(fmaxf(b, p0[r + 2]), p0[r + 3]); a = fmaxf(fmaxf(a, p1[r]), p1[r + 1]); b = fmaxf(fmaxf(b, p1[r + 2]), p1[r + 3]); }
  float pmax = fmaxf(a, b);
  { auto rr = __builtin_amdgcn_permlane32_swap(__float_as_uint(pmax), __float_as_uint(pmax), false, false);
    pmax = fmaxf(__uint_as_float(rr[0]), __uint_as_float(rr[1])); }
  if (__builtin_expect(__all(pmax - m_reg <= THR), 1)) { mn = m_reg; alpha = 1.f; }
  else { mn = fmaxf(m_reg, pmax); alpha = __builtin_amdgcn_exp2f(m_reg - mn); m_reg = mn; }
#pragma unroll
  for (int r = 0; r < 16; ++r) p0[r] = fsub_s(p0[r], mn);
#pragma unroll
  for (int r = 0; r < 16; ++r) p1[r] = fsub_s(p1[r], mn);
#pragma unroll
  for (int r = 0; r < 16; ++r) p0[r] = __builtin_amdgcn_exp2f(p0[r]);
}
template <bool ONES>
__device__ __forceinline__ void finishSM(f32x16& p0, f32x16& p1, float alpha, float& l_reg, bf16x8& pa0, bf16x8& pa1, bf16x8& pa2, bf16x8& pa3) {
#pragma unroll
  for (int r = 0; r < 16; ++r) p1[r] = __builtin_amdgcn_exp2f(p1[r]);
  if constexpr (!ONES) {
    float ps = 0.f;
#pragma unroll
    for (int r = 0; r < 16; ++r) ps += p0[r];
#pragma unroll
    for (int r = 0; r < 16; ++r) ps += p1[r];
    { auto rr = __builtin_amdgcn_permlane32_swap(__float_as_uint(ps), __float_as_uint(ps), false, false);
      ps = __uint_as_float(rr[0]) + __uint_as_float(rr[1]); }
    l_reg = l_reg * alpha + ps;
  }
#define PK4(P, BASE, OUT) do { unsigned a0 = cvtpk(P[BASE + 0], P[BASE + 1]), a1 = cvtpk(P[BASE + 2], P[BASE + 3]);   \
    unsigned b0 = cvtpk(P[BASE + 4], P[BASE + 5]), b1 = cvtpk(P[BASE + 6], P[BASE + 7]);                              \
    auto r0 = __builtin_amdgcn_permlane32_swap(a0, b0, false, false); auto r1 = __builtin_amdgcn_permlane32_swap(a1, b1, false, false); \
    u32x4 w = {r0[0], r1[0], r0[1], r1[1]}; OUT = *reinterpret_cast<bf16x8*>(&w); } while (0)
  PK4(p0, 0, pa0); PK4(p0, 8, pa1); PK4(p1, 0, pa2); PK4(p1, 8, pa3);
#undef PK4
}
template <int DQK>
__device__ __forceinline__ void qkt(f32x16& p0, f32x16& p1, const char* Ks, const bf16x8 (&qr)[DQK / 16], int r32, int hi) {
  constexpr int KSTR = DQK * 2 + 16;
  p0 = f32x16{}; p1 = f32x16{};
#pragma unroll
  for (int d0 = 0; d0 < DQK / 16; ++d0) { const int cb = (d0 * 16 + hi * 8) * 2;
    bf16x8 b0 = *reinterpret_cast<const bf16x8*>(Ks + r32 * KSTR + cb);
    bf16x8 b1 = *reinterpret_cast<const bf16x8*>(Ks + (32 + r32) * KSTR + cb);
    p0 = __builtin_amdgcn_mfma_f32_32x32x16_bf16(b0, qr[d0], p0, 0, 0, 0);
    p1 = __builtin_amdgcn_mfma_f32_32x32x16_bf16(b1, qr[d0], p1, 0, 0, 0); }
}
template <int DV> __device__ __forceinline__ int v_st(int k, int c) { const int kk = (k & ~0xC) | ((k & 4) << 1) | ((k & 8) >> 1); return ((kk >> 3) * (DV / 32) + (c >> 5)) * 512 + ((kk & 7) * 32 + (c & 31)) * 2; }
__device__ __forceinline__ int v_rd_base(int lane) { return ((lane & 3) << 3) | (((lane >> 2) & 3) << 6) | (((lane >> 4) & 1) << 5) | (((lane >> 5) & 1) << 8); }
template <int DV> constexpr int v_rd_off(int d0, int ks, int half) { return d0 * 512 + (2 * ks + half) * (DV / 32) * 512; }
template <int OFF> __device__ __forceinline__ s16x4 tr_read(int vb) {
  s16x4 r; asm volatile("ds_read_b64_tr_b16 %0, %1 offset:%2" : "=&v"(r) : "v"(vb), "i"(OFF) : "memory"); return r;
}
template <int DV, int D0> __device__ __forceinline__ void pv_one(f32x16& od, int vb, bf16x8 pa0, bf16x8 pa1, bf16x8 pa2, bf16x8 pa3) {
  const s16x4 l0 = tr_read<v_rd_off<DV>(D0, 0, 0)>(vb), h0 = tr_read<v_rd_off<DV>(D0, 0, 1)>(vb), l1 = tr_read<v_rd_off<DV>(D0, 1, 0)>(vb), h1 = tr_read<v_rd_off<DV>(D0, 1, 1)>(vb);
  const s16x4 l2 = tr_read<v_rd_off<DV>(D0, 2, 0)>(vb), h2 = tr_read<v_rd_off<DV>(D0, 2, 1)>(vb), l3 = tr_read<v_rd_off<DV>(D0, 3, 0)>(vb), h3 = tr_read<v_rd_off<DV>(D0, 3, 1)>(vb);
  asm volatile("s_waitcnt lgkmcnt(0)" ::: "memory"); SBAR();
#define PK(L, H) (bf16x8){L[0], L[1], L[2], L[3], H[0], H[1], H[2], H[3]}
  od = __builtin_amdgcn_mfma_f32_32x32x16_bf16(pa0, PK(l0, h0), od, 0, 0, 0);
  od = __builtin_amdgcn_mfma_f32_32x32x16_bf16(pa1, PK(l1, h1), od, 0, 0, 0);
  od = __builtin_amdgcn_mfma_f32_32x32x16_bf16(pa2, PK(l2, h2), od, 0, 0, 0);
  od = __builtin_amdgcn_mfma_f32_32x32x16_bf16(pa3, PK(l3, h3), od, 0, 0, 0);
#undef PK
}
template <int DV> __device__ __forceinline__ void pv_all(f32x16 (&o)[DV / 32], int vb, bf16x8 pa0, bf16x8 pa1, bf16x8 pa2, bf16x8 pa3) {
  pv_one<DV, 0>(o[0], vb, pa0, pa1, pa2, pa3); pv_one<DV, 1>(o[1], vb, pa0, pa1, pa2, pa3);
  if constexpr (DV == 128) { pv_one<DV, 2>(o[2], vb, pa0, pa1, pa2, pa3); pv_one<DV, 3>(o[3], vb, pa0, pa1, pa2, pa3); }
}

struct KVSrc { const bf16_t* K; int ldk; const bf16_t* K2; int ldk2; const bf16_t* V; int ldv; };

template <int DQK, int DV, bool ONES>
__device__ __forceinline__ void attn_body(const bf16x8 (&qr)[DQK / 16], const KVSrc s, f32x16 (&o)[DV / 32], char* lds, int seq) {
  constexpr int KSTR = DQK * 2 + 16, SHM_V = 64 * DV * 2, SHM_K = 64 * KSTR;
  constexpr int NCHK = DQK / 8, NKI = (64 * NCHK + 511) / 512, NCHV = DV / 8, NVI = (64 * NCHV) / 512;
  const int tid = launder_i(threadIdx.x), wid = tid >> 6, lane = tid & 63, r32 = lane & 31, hi = lane >> 5;
  char* V_lds = lds; char* K_lds = lds + 3 * SHM_V;
  float* ws = (float*)(lds + 3 * SHM_V + 3 * SHM_K) + wid * 64; float* li_l = ws; float* al_l = ws + 32;
  float m_reg = -1e30f, l_reg = 0.f;
  f32x16 ol = f32x16{};
  const bf16x8 ones = {16256, 16256, 16256, 16256, 16256, 16256, 16256, 16256};
#pragma unroll
  for (int d = 0; d < DV / 32; ++d) o[d] = f32x16{};
  const bf16_t* kp[NKI]; long kstep[NKI]; int kdst[NKI]; bool kval[NKI];
#pragma unroll
  for (int i = 0; i < NKI; ++i) { const int c = tid + 512 * i; kval[i] = c < 64 * NCHK; const int cc = kval[i] ? c : 0; const int row = cc / NCHK, ch = cc % NCHK;
    if (ch < 8) { kp[i] = s.K + (long)row * s.ldk + ch * 8; kstep[i] = 64L * s.ldk; } else { kp[i] = s.K2 + (long)row * s.ldk2 + (ch - 8) * 8; kstep[i] = 64L * s.ldk2; }
    kdst[i] = row * KSTR + ch * 16; }
  const bf16_t* vp[NVI]; int vdst[NVI]; const long vstep = 64L * s.ldv;
#pragma unroll
  for (int i = 0; i < NVI; ++i) { const int c = tid + 512 * i; const int row = c / NCHV, ch = c % NCHV; vp[i] = s.V + (long)row * s.ldv + ch * 8; vdst[i] = v_st<DV>(row, ch * 8); }
  const int vb0 = (int)(uintptr_t)V_lds + v_rd_base(lane);
  bf16x8 sk0[NKI], sk1[NKI], sv0[NVI], sv1[NVI];
#define SLOAD(SK, SV, t) do { _Pragma("unroll") for (int i_ = 0; i_ < NKI; ++i_) SK[i_] = *reinterpret_cast<const bf16x8*>(kp[i_] + (long)(t) * kstep[i_]); \
    _Pragma("unroll") for (int i_ = 0; i_ < NVI; ++i_) SV[i_] = *reinterpret_cast<const bf16x8*>(vp[i_] + (long)(t) * vstep); } while (0)
#define SWRITE(b, SK, SV) do { _Pragma("unroll") for (int i_ = 0; i_ < NVI; ++i_) *(bf16x8*)(V_lds + (b) * SHM_V + vdst[i_]) = SV[i_]; \
    _Pragma("unroll") for (int i_ = 0; i_ < NKI; ++i_) if (kval[i_]) *(bf16x8*)(K_lds + (b) * SHM_K + kdst[i_]) = SK[i_]; } while (0)
#define SWAIT() asm volatile("s_waitcnt vmcnt(%0)" :: "n"(NKI + NVI) : "memory")
#define RESC(a) do { if (__any((a) < 1.f)) { if (hi == 0) al_l[r32] = (a); asm volatile("s_waitcnt lgkmcnt(0)" ::: "memory"); \
    _Pragma("unroll") for (int r = 0; r < 16; ++r) { const float f_ = al_l[crow(r, hi)]; if constexpr (ONES) ol[r] *= f_; \
      _Pragma("unroll") for (int d = 0; d < DV / 32; ++d) o[d][r] *= f_; } } } while (0)
#define PVALL(vb) do { pv_all<DV>(o, (vb), pa0, pa1, pa2, pa3); if constexpr (ONES) { \
    ol = __builtin_amdgcn_mfma_f32_32x32x16_bf16(pa0, ones, ol, 0, 0, 0); ol = __builtin_amdgcn_mfma_f32_32x32x16_bf16(pa1, ones, ol, 0, 0, 0); \
    ol = __builtin_amdgcn_mfma_f32_32x32x16_bf16(pa2, ones, ol, 0, 0, 0); ol = __builtin_amdgcn_mfma_f32_32x32x16_bf16(pa3, ones, ol, 0, 0, 0); } } while (0)
#define ROT() do { const int t_ = bp; bp = bc; bc = bn; bn = t_; } while (0)
  f32x16 pA0, pA1, pB0, pB1; float mnA, mnB, alA, alB; bf16x8 pa0, pa1, pa2, pa3; const int NT = seq / 64;
  int bp = 0, bc = 1, bn = 2;
  __syncthreads();
  SLOAD(sk0, sv0, 0); asm volatile("s_waitcnt vmcnt(0)" ::: "memory"); SWRITE(0, sk0, sv0);
  SLOAD(sk1, sv1, 1); if (2 < NT) SLOAD(sk0, sv0, 2);
  __syncthreads();
  qkt<DQK>(pA0, pA1, K_lds, qr, r32, hi); partialSM(pA0, pA1, m_reg, mnA, alA);
  SWAIT(); SWRITE(1, sk1, sv1); __syncthreads();
  for (int j = 1; j + 1 < NT; j += 2) {
    SBAR(); qkt<DQK>(pB0, pB1, K_lds + bc * SHM_K, qr, r32, hi);
    finishSM<ONES>(pA0, pA1, alA, l_reg, pa0, pa1, pa2, pa3); SBAR();
    SLOAD(sk1, sv1, j + 2); SBAR();
    PVALL(vb0 + bp * SHM_V); partialSM(pB0, pB1, m_reg, mnB, alB);
    SWAIT(); SWRITE(bn, sk0, sv0);
    RESC(alB); __syncthreads(); ROT();
    SBAR(); qkt<DQK>(pA0, pA1, K_lds + bc * SHM_K, qr, r32, hi);
    finishSM<ONES>(pB0, pB1, alB, l_reg, pa0, pa1, pa2, pa3); SBAR();
    if (j + 3 < NT) SLOAD(sk0, sv0, j + 3); SBAR();
    PVALL(vb0 + bp * SHM_V); partialSM(pA0, pA1, m_reg, mnA, alA);
    SWAIT(); SWRITE(bn, sk1, sv1);
    RESC(alA); __syncthreads(); ROT();
  }
  SBAR(); qkt<DQK>(pB0, pB1, K_lds + bc * SHM_K, qr, r32, hi);
  finishSM<ONES>(pA0, pA1, alA, l_reg, pa0, pa1, pa2, pa3); SBAR();
  PVALL(vb0 + bp * SHM_V); partialSM(pB0, pB1, m_reg, mnB, alB);
  RESC(alB);
  finishSM<ONES>(pB0, pB1, alB, l_reg, pa0, pa1, pa2, pa3); SBAR();
  PVALL(vb0 + bc * SHM_V);
  if constexpr (ONES) {
#pragma unroll
    for (int r = 0; r < 16; ++r) { const float rl = __builtin_amdgcn_rcpf(ol[r]);
#pragma unroll
      for (int d = 0; d < DV / 32; ++d) o[d][r] *= rl; }
  } else {
    if (hi == 0) li_l[r32] = l_reg; asm volatile("s_waitcnt lgkmcnt(0)" ::: "memory");
#pragma unroll
    for (int r = 0; r < 16; ++r) { const float rl = __builtin_amdgcn_rcpf(li_l[crow(r, hi)]);
#pragma unroll
      for (int d = 0; d < DV / 32; ++d) o[d][r] *= rl; }
  }
#undef SLOAD
#undef SWRITE
#undef SWAIT
#undef RESC
#undef PVALL
#undef ROT
}
}

#define LAS __attribute__((address_space(3)))
typedef unsigned short bf16_t;
typedef unsigned v4u __attribute__((ext_vector_type(4)));
typedef unsigned v2u __attribute__((ext_vector_type(2)));
typedef float f32x4 __attribute__((ext_vector_type(4)));
typedef float f32x2 __attribute__((ext_vector_type(2)));

constexpr int NB = 8, SEQ = 4096, DM = 1024, NT_TOK = NB * SEQ;
constexpr int EV_IN = 3328, OD_INP = 1536;
constexpr float ALPHA = 1.6817928305074290f;
constexpr float LN_EPS = 1e-5f, RMS_EPS = 1e-6f;
constexpr float LOG2E = 1.4426950408889634f;
constexpr float QS_64 = 0.125f * LOG2E;
constexpr float QS_96 = 0.10206207261596575f * LOG2E;

constexpr size_t MiB = 1u << 20;
constexpr size_t WS_TAB = 0;
constexpr size_t TAB_A_COS = 0, TAB_A_SIN = 131072, TAB_C_COS = 262144, TAB_C_SIN = 524288, TAB_X_COS = 786432, TAB_X_SIN = 790528;
constexpr size_t WS_BAR = 917504, WS_BAR_BYTES = 16384;
constexpr size_t WS_EVIN = 1 * MiB, SZ_EVIN = (size_t)EV_IN * 1024 * 2;
constexpr size_t WS_EVOUT = 14 * MiB, SZ_SQ = 2 * MiB;
constexpr size_t WS_ODIN = 18 * MiB, SZ_ODIN = 3 * MiB;
constexpr size_t WS_QB = 24 * MiB, SZ_QB = (size_t)1536 * 256 * 2;
constexpr size_t WS_KVB = 26 * MiB, SZ_KVB = (size_t)2048 * 128 * 2;
constexpr size_t WS_ODOUT = 27 * MiB;
constexpr size_t WS_XB = 32 * MiB;
constexpr size_t WS_OG = 96 * MiB;
constexpr size_t WS_Y = 160 * MiB;
constexpr size_t WS_H = 288 * MiB;
constexpr size_t WS_QC = WS_H, WS_GATE = WS_H + 96 * MiB, WS_CQN = WS_H + 160 * MiB, WS_CKVN = WS_H + 176 * MiB, WS_KRR = WS_H + 184 * MiB;
constexpr size_t WS_END = 496 * MiB;
constexpr int LDS_BYTES = 131072 + 1024;

struct Params {
  const float* x; const float* ev_w_in; const float* ev_w_out; const float* ev_lam; const float* ev_subln; const float* ev_qnorm; const float* ev_knorm;
  const float* ev_ln_g; const float* ev_ln_b; const float* od_w_in; const float* od_qnorm; const float* od_kvnorm; const float* od_w_qb; const float* od_w_kvb;
  const float* od_w_out; const float* od_ln_g; const float* od_ln_b; float* out; unsigned char* ws;
};

__device__ __forceinline__ unsigned f2bf_rne(float f) { unsigned u = __builtin_bit_cast(unsigned, f); return (u + 0x7fffu + ((u >> 16) & 1u)) >> 16; }
__device__ __forceinline__ unsigned pk2(float lo, float hi) { return f2bf_rne(lo) | (f2bf_rne(hi) << 16); }
__device__ __forceinline__ float wave_sum(float v) {
#pragma unroll
  for (int o = 1; o < 64; o <<= 1) v += __shfl_xor(v, o);
  return v;
}
__device__ __forceinline__ void transpose_item(const float* W, int K, int N, bf16_t* WT, int kb, int nb, int row_off, LAS float* scr, int lane) {
  const int k0 = 64 * kb, n0 = 32 * nb;
#pragma unroll 8
  for (int i = 0; i < 32; ++i) { const int kk = 2 * i + (lane >> 5); scr[kk * 33 + (lane & 31)] = W[(size_t)(k0 + kk) * N + n0 + (lane & 31)]; }
  asm volatile("s_waitcnt lgkmcnt(0)" ::: "memory");
  const int c = lane & 7;
#pragma unroll
  for (int j = 0; j < 4; ++j) { const int n = (lane >> 3) + 8 * j; const LAS float* s = scr + (8 * c) * 33 + n;
    v4u o; o.x = pk2(s[0 * 33], s[1 * 33]); o.y = pk2(s[2 * 33], s[3 * 33]); o.z = pk2(s[4 * 33], s[5 * 33]); o.w = pk2(s[6 * 33], s[7 * 33]);
    *(v4u*)(WT + (size_t)(row_off + n0 + n) * K + k0 + 8 * c) = o; }
  asm volatile("s_waitcnt lgkmcnt(0)" ::: "memory");
}
__device__ __forceinline__ void unpack8(v4u raw, float (&v)[8]) {
  v[0] = __uint_as_float(raw.x << 16); v[1] = __uint_as_float(raw.x & 0xffff0000u); v[2] = __uint_as_float(raw.y << 16); v[3] = __uint_as_float(raw.y & 0xffff0000u);
  v[4] = __uint_as_float(raw.z << 16); v[5] = __uint_as_float(raw.z & 0xffff0000u); v[6] = __uint_as_float(raw.w << 16); v[7] = __uint_as_float(raw.w & 0xffff0000u);
}
__device__ __forceinline__ v4u pack8(const float (&v)[8]) { v4u w; w.x = pk2(v[0], v[1]); w.y = pk2(v[2], v[3]); w.z = pk2(v[4], v[5]); w.w = pk2(v[6], v[7]); return w; }

#define XB_TMO      128
#define XB_XCNT(j)  (256  + 64 * (j))
#define XB_XSUB(j)  (1280 + 64 * (j))
#define XB_XGEN(j)  (2304 + 64 * (j))
#define XB_TOP      3328
#define XB_TOPGEN   3392
#define XCD_BAR_WORDS 3456
#define XB_SPIN_CAP (1u << 18)

__device__ __forceinline__ unsigned xb_ld(unsigned* p)              { return __hip_atomic_load(p, __ATOMIC_RELAXED, __HIP_MEMORY_SCOPE_AGENT); }
__device__ __forceinline__ unsigned xb_add(unsigned* p, unsigned v) { return __hip_atomic_fetch_add(p, v, __ATOMIC_RELAXED, __HIP_MEMORY_SCOPE_AGENT); }
__device__ __forceinline__ unsigned xb_xcc_id() { return (unsigned)__builtin_amdgcn_s_getreg((3 << 11) | 20) & 0xFu; }
#define XB_SPIN(cond, bar) do { unsigned _sp = 0; while (cond) { __builtin_amdgcn_s_sleep(1); \
    if ((++_sp & 255u) == 0u) { if (xb_ld(&(bar)[XB_TMO])) break; if (_sp > XB_SPIN_CAP) { atomicAdd(&(bar)[XB_TMO], 1u); break; } } } } while (0)

struct XcdBarrier {
    unsigned* bar; unsigned x;
    volatile LAS unsigned* st;
};

__device__ __forceinline__ XcdBarrier xcd_barrier_post(unsigned* bar, volatile LAS unsigned* st) {
    XcdBarrier b; b.bar = bar; b.x = xb_xcc_id(); b.st = st;
    if (threadIdx.x == 0) (void)xb_add(&bar[XB_XCNT(b.x)], 1u);
    return b;
}
__device__ __forceinline__ void xcd_barrier_complete(unsigned* bar, unsigned x, unsigned& nloc, unsigned& nx) {
    const unsigned G = gridDim.x * gridDim.y * gridDim.z;
    unsigned sum, cnt, mine, sp = 0u;
    for (;;) {
        sum = 0u; cnt = 0u; mine = 0u;
#pragma unroll
        for (unsigned j = 0; j < 16; ++j) { const unsigned c = xb_ld(&bar[XB_XCNT(j)]); sum += c; cnt += (c > 0u) ? 1u : 0u; mine = (j == x) ? c : mine; }
        if (sum == G) break;
        __builtin_amdgcn_s_sleep(1);
        if ((++sp & 255u) == 0u) { if (xb_ld(&bar[XB_TMO])) break; if (sp > XB_SPIN_CAP) { atomicAdd(&bar[XB_TMO], 1u); break; } }
    }
    nloc = mine > 0u ? mine : 1u; nx = cnt > 0u ? cnt : 1u;
}

__device__ __forceinline__ void xcd_barrier(const XcdBarrier& b) {
    asm volatile("s_waitcnt vmcnt(0)" ::: "memory");
    __syncthreads();
    if (threadIdx.x == 0) {
        unsigned* bar = b.bar;
        __builtin_amdgcn_s_waitcnt(0);
        unsigned nloc = b.st[0], nx = b.st[1];
        if (nloc == 0u) { xcd_barrier_complete(bar, b.x, nloc, nx); b.st[0] = nloc; b.st[1] = nx; }
        const unsigned old = xb_add(&bar[XB_XSUB(b.x)], 1u);
        const unsigned gen = old / nloc;
        if (old + 1u == (gen + 1u) * nloc) {
            __builtin_amdgcn_fence(__ATOMIC_RELEASE, "agent");
            asm volatile("s_waitcnt vmcnt(0)" ::: "memory");
            const unsigned og = xb_add(&bar[XB_TOP], 1u);
            const unsigned tg = og / nx;
            if (og + 1u == (tg + 1u) * nx) xb_add(&bar[XB_TOPGEN], 1u);
            else XB_SPIN(xb_ld(&bar[XB_TOPGEN]) == tg, bar);
            __builtin_amdgcn_fence(__ATOMIC_ACQUIRE, "agent");
            xb_add(&bar[XB_XGEN(b.x)], 1u);
            asm volatile("s_waitcnt vmcnt(0)" ::: "memory");
        } else {
            XB_SPIN(xb_ld(&bar[XB_XGEN(b.x)]) == gen, bar);
            __builtin_amdgcn_fence(__ATOMIC_ACQUIRE, "agent");
            asm volatile("s_waitcnt vmcnt(0)" ::: "memory");
        }
    }
    __syncthreads();
}
#ifndef ATT_ONES_A
#define ATT_ONES_A false
#endif
#ifndef ATT_ONES_B
#define ATT_ONES_B true
#endif
#ifndef ATT_ONES_C
#define ATT_ONES_C true
#endif
#ifdef REP_SYNC
#define GSYNC() do { for (int rs_ = 0; rs_ < REP_SYNC; ++rs_) xcd_barrier(bar); } while (0)
#else
#define GSYNC() xcd_barrier(bar)
#endif
typedef const __attribute__((address_space(4))) Params* CParams;
__device__ __forceinline__ CParams get_params() { CParams q = (CParams)__builtin_amdgcn_kernarg_segment_ptr(); asm volatile("" : "+s"(q)); return q; }
struct Ctx { int G, bid, vcu, GX, xcd, lcu, xmode, NGW; };
#define PHASE_IDS() const int tid = launder_i(threadIdx.x), lane = tid & 63, wave = __builtin_amdgcn_readfirstlane(tid >> 6), r32 = lane & 31, hi = lane >> 5; const int gw = C.vcu * 8 + wave; \
    (void)r32; (void)hi; (void)gw; (void)lane; CParams P = get_params(); unsigned char* ws = P->ws

__device__ __forceinline__ void phase_prologue(const Ctx C, unsigned char* lds) {
  PHASE_IDS();
  LAS float* scr = (LAS float*)((LAS unsigned char*)lds + wave * 16384);
  constexpr int I_EVIN = 16 * 104, I_SQ = 16 * 32, I_ODIN = 16 * 45, I_QB = 4 * 48, I_KVB = 2 * 64, PER = I_EVIN + I_SQ + I_ODIN + I_QB + I_KVB + I_SQ;
#pragma unroll 1
  for (int it = gw; it < 2 * PER; it += C.NGW) {
    const int i = it / PER; int r = it - i * PER;
    const float* W; int K, N, kb, nb, row_off = 0; bf16_t* WT;
    if (r < I_EVIN) { W = P->ev_w_in + (size_t)i * 1024 * EV_IN; K = 1024; N = EV_IN; WT = (bf16_t*)(ws + WS_EVIN + i * SZ_EVIN); kb = r / 104; nb = r % 104; }
    else if ((r -= I_EVIN) < I_SQ) { W = P->ev_w_out + (size_t)i * 1024 * 1024; K = 1024; N = 1024; WT = (bf16_t*)(ws + WS_EVOUT + i * SZ_SQ); kb = r / 32; nb = r % 32; }
    else if ((r -= I_SQ) < I_ODIN) { W = P->od_w_in + (size_t)i * 1024 * 1440; K = 1024; N = 1440; WT = (bf16_t*)(ws + WS_ODIN + i * SZ_ODIN); kb = r / 45; nb = r % 45; row_off = nb < 13 ? 0 : 96; }
    else if ((r -= I_ODIN) < I_QB) { W = P->od_w_qb + (size_t)i * 256 * 1536; K = 256; N = 1536; WT = (bf16_t*)(ws + WS_QB + i * SZ_QB); kb = r / 48; nb = r % 48; }
    else if ((r -= I_QB) < I_KVB) { W = P->od_w_kvb + (size_t)i * 128 * 2048; K = 128; N = 2048; WT = (bf16_t*)(ws + WS_KVB + i * SZ_KVB); kb = r / 64; nb = r % 64; }
    else { r -= I_KVB; W = P->od_w_out + (size_t)i * 1024 * 1024; K = 1024; N = 1024; WT = (bf16_t*)(ws + WS_ODOUT + i * SZ_SQ); kb = r / 32; nb = r % 32; }
    transpose_item(W, K, N, WT, kb, nb, row_off, scr, lane);
  }
  const int gt = C.vcu * 512 + tid, NGT = C.G * 512;
  for (int idx = gt; idx < 2 * 12288; idx += NGT) { const int i = idx / 12288, r = idx - i * 12288; *(v4u*)(ws + WS_ODIN + i * SZ_ODIN + (size_t)416 * 1024 * 2 + (size_t)r * 16) = (v4u){0u, 0u, 0u, 0u}; }
  for (int idx = gt; idx < 32768 + 65536 + 1024; idx += NGT) {
    int pos, fi, nf; float theta; float* tc; float* tsn;
    if (idx < 32768) { pos = idx >> 3; fi = idx & 7; nf = 8; theta = 500000.f; tc = (float*)(ws + TAB_A_COS) + idx; tsn = (float*)(ws + TAB_A_SIN) + idx; }
    else if (idx < 32768 + 65536) { const int k = idx - 32768; pos = k >> 4; fi = k & 15; nf = 16; theta = 500000.f; tc = (float*)(ws + TAB_C_COS) + k; tsn = (float*)(ws + TAB_C_SIN) + k; }
    else { const int k = idx - 32768 - 65536; pos = k >> 4; fi = k & 15; nf = 16; theta = 10000.f; tc = (float*)(ws + TAB_X_COS) + k; tsn = (float*)(ws + TAB_X_SIN) + k; }
    const float inv = (float)exp2(-(double)fi / (double)nf * log2((double)theta));
    const float ang = (float)pos * inv;
    double rev = (double)ang * 0.15915494309189535; rev -= floor(rev);
    const float rf = (float)rev;
    *tc = __builtin_amdgcn_cosf(rf); *tsn = __builtin_amdgcn_sinf(rf);
  }
  const float* x = P->x; bf16_t* XB = (bf16_t*)(ws + WS_XB);
#pragma unroll 2
  for (int idx = gt; idx < NT_TOK * DM / 8; idx += NGT) { const f32x4 a = *(const f32x4*)(x + (size_t)idx * 8), b = *(const f32x4*)(x + (size_t)idx * 8 + 4);
    v4u w; w.x = pk2(a[0], a[1]); w.y = pk2(a[2], a[3]); w.z = pk2(b[0], b[1]); w.w = pk2(b[2], b[3]); *(v4u*)(XB + (size_t)idx * 8) = w; }
}

__device__ __forceinline__ void phase_gemm_e1(const Ctx C, unsigned char* lds, int li) {
  CParams P = get_params(); unsigned char* ws = P->ws;
  pg8::Gemm g{(const bf16_t*)(ws + WS_XB), (const bf16_t*)(ws + WS_EVIN + li * SZ_EVIN), NT_TOK, EV_IN, 1024}; pg8::StaticOrder So; So.init(NT_TOK, EV_IN, C.G, C.bid);
  pg8::EpiBf16S E{(bf16_t*)(ws + WS_H), EV_IN, 2304, 1.f, 0};
#ifndef NO_E1
  pg8::gemm_phase<pg8::EpiBf16S, pg8::StaticOrder, true, true>((LAS unsigned char*)lds, g, So, E);
#endif
}
__device__ __forceinline__ void phase_gemm_o1(const Ctx C, unsigned char* lds, int li) {
  CParams P = get_params(); unsigned char* ws = P->ws;
  pg8::Gemm g{(const bf16_t*)(ws + WS_XB), (const bf16_t*)(ws + WS_ODIN + li * SZ_ODIN), NT_TOK, OD_INP, 1024}; pg8::StaticOrder So; So.init(NT_TOK, OD_INP, C.G, C.bid);
  pg8::EpiOddIn E{(float*)(ws + WS_OG), (bf16_t*)(ws + WS_GATE)};
#ifndef NO_O1
  pg8::gemm_phase<pg8::EpiOddIn, pg8::StaticOrder, true, true>((LAS unsigned char*)lds, g, So, E);
#endif
}
__device__ __forceinline__ void phase_gemm_o3(const Ctx C, unsigned char* lds, int li) {
#pragma unroll 1
  for (int which = 0; which < 2; ++which) {
    CParams P = get_params(); unsigned char* ws = P->ws;
    const int N = which ? 2048 : 1536, K = which ? 128 : 256;
    pg8::Gemm g{(const bf16_t*)(ws + (which ? WS_CKVN : WS_CQN)), (const bf16_t*)(ws + (which ? WS_KVB + li * SZ_KVB : WS_QB + li * SZ_QB)), NT_TOK, N, K};
    pg8::StaticOrder So; So.init(NT_TOK, N, C.G, C.bid);
    pg8::EpiBf16S E{(bf16_t*)(ws + (which ? WS_Y : WS_QC)), N, 1 << 30, which ? 1.f : QS_96, 1 << 30};
#ifndef NO_O3
    pg8::gemm_phase<pg8::EpiBf16S, pg8::StaticOrder, true, true>((LAS unsigned char*)lds, g, So, E);
#endif
  }
}
__device__ __forceinline__ void phase_gemm_out(const Ctx C, unsigned char* lds, int layer) {
  CParams P = get_params(); unsigned char* ws = P->ws;
  const bf16_t* Wt = (const bf16_t*)(ws + ((layer & 1) ? WS_ODOUT : WS_EVOUT) + (layer >> 1) * SZ_SQ);
  pg8::Gemm g{(const bf16_t*)(ws + WS_OG), Wt, NT_TOK, 1024, 1024}; pg8::StaticOrder So; So.init(NT_TOK, 1024, C.G, C.bid);
  pg8::EpiF32 E{(float*)(ws + WS_Y), 1024};
#ifndef NO_OUT
  pg8::gemm_phase<pg8::EpiF32, pg8::StaticOrder, true, true>((LAS unsigned char*)lds, g, So, E);
#endif
}

__device__ __forceinline__ void phase_e2(const Ctx C, int li) {
  PHASE_IDS();
  const int grp = (C.vcu * 512 + tid) >> 3, j = tid & 7, NGRP = C.G * 64;
  const float* qn = P->ev_qnorm + li * 64; const float* kn = P->ev_knorm + li * 64;
  bf16_t* H = (bf16_t*)(ws + WS_H);
  const float* tabAc = (const float*)(ws + TAB_A_COS); const float* tabAs = (const float*)(ws + TAB_A_SIN);
  const float* tabXc = (const float*)(ws + TAB_X_COS); const float* tabXs = (const float*)(ws + TAB_X_SIN);
#pragma unroll 1
  for (int it = grp; it < NT_TOK * 26; it += NGRP) {
    const int t = it / 26, ci = it - t * 26, pos = t & (SEQ - 1);
    const int col = ci < 16 ? ci * 64 : (ci < 24 ? 1536 + (ci - 16) * 64 : 2048 + (ci - 24) * 64);
    bf16_t* ptr = H + (size_t)t * EV_IN + col + j * 8;
    float v[8], pr[8]; unpack8(*(const v4u*)ptr, v);
    if (ci < 16) {
#pragma unroll
      for (int k = 0; k < 8; ++k) pr[k] = __shfl_xor(v[k], 1);
      if (j < 2) {
#pragma unroll
        for (int k = 0; k < 8; ++k) { const float c = tabAc[pos * 8 + k], s = tabAs[pos * 8 + k]; v[k] = j == 0 ? v[k] * c - pr[k] * s : v[k] * c + pr[k] * s; }
      }
    } else {
      float ss = 0.f;
#pragma unroll
      for (int k = 0; k < 8; ++k) ss += v[k] * v[k];
      ss += __shfl_xor(ss, 1); ss += __shfl_xor(ss, 2); ss += __shfl_xor(ss, 4);
      const float rinv = 1.0f / sqrtf(ss * (1.0f / 64.0f) + RMS_EPS);
      const float* g = ci < 24 ? qn : kn;
#pragma unroll
      for (int k = 0; k < 8; ++k) v[k] = v[k] * rinv * g[j * 8 + k];
#pragma unroll
      for (int k = 0; k < 8; ++k) pr[k] = __shfl_xor(v[k], 2);
      const int tp = (j < 4) ? (pos >> 6) : (pos & 63), fi = (j & 1) * 8;
#pragma unroll
      for (int k = 0; k < 8; ++k) { const float c = tabXc[tp * 16 + fi + k], s = tabXs[tp * 16 + fi + k]; v[k] = (j & 2) ? v[k] * c + pr[k] * s : v[k] * c - pr[k] * s; }
    }
    if (ci < 8 || (ci >= 16 && ci < 24)) {
#pragma unroll
      for (int k = 0; k < 8; ++k) v[k] *= QS_64;
    }
    *(v4u*)ptr = pack8(v);
  }
}

__device__ __forceinline__ void phase_e3(const Ctx C, unsigned char* lds, int layer) {
  const int li = layer >> 1;
  const float lam_init = layer == 0 ? 0.2f : 0.47071301834305566f;
#pragma unroll 1
  for (int s_ = 0;; ++s_) {
    int u; if (C.xmode) { const int idx = C.lcu + s_ * C.GX; if (idx >= 64) break; u = C.xcd * 64 + idx; } else { u = C.bid + s_ * C.G; if (u >= 512) break; }
    const int bh = u >> 4, qb = u & 15, b = bh >> 2, h = bh & 3;
    const size_t rowb = (size_t)b * SEQ;
    att::f32x16 o[4];
#pragma unroll 1
    for (int c = 0; c < 2; ++c) {
      PHASE_IDS();
      bf16_t* H = (bf16_t*)(ws + WS_H);
      const size_t roww = rowb + qb * 256 + wave * 32;
      att::bf16x8 qr[4];
      { const bf16_t* Qw = H + (roww + r32) * EV_IN + h * 128 + c * 64 + hi * 8;
#pragma unroll
        for (int d0 = 0; d0 < 4; ++d0) qr[d0] = *reinterpret_cast<const att::bf16x8*>(Qw + d0 * 16); }
      att::KVSrc kv{H + rowb * EV_IN + 512 + h * 128 + c * 64, EV_IN, nullptr, 0, H + rowb * EV_IN + 1024 + h * 128, EV_IN};
#ifndef NO_A
      att::attn_body<64, 128, ATT_ONES_A>(qr, kv, o, (char*)lds, SEQ);
#endif
      if (c == 0) {
        const int l2 = launder_i(threadIdx.x) & 63;
        float* scrA = (float*)(ws + WS_Y) + ((size_t)C.bid * 8 + wave) * 4096;
#pragma unroll
        for (int r = 0; r < 16; ++r) { float* pr_ = scrA + launder_i(r * 256 + l2);
#pragma unroll
          for (int d0 = 0; d0 < 4; ++d0) pr_[d0 * 64] = o[d0][r]; }
      }
    }
    {
      PHASE_IDS();
      float lam;
      { const float* lp = P->ev_lam + li * 256; const float d1 = wave_sum(lp[lane] * lp[64 + lane]), d2 = wave_sum(lp[128 + lane] * lp[192 + lane]); lam = expf(d1) - expf(d2) + lam_init; }
      const float* subln = P->ev_subln + li * 128;
      const bf16_t* H = (const bf16_t*)(ws + WS_H); bf16_t* OG = (bf16_t*)(ws + WS_OG);
      const float* scrA = (const float*)(ws + WS_Y) + ((size_t)C.bid * 8 + wave) * 4096;
      const size_t roww = rowb + qb * 256 + wave * 32;
      const float post = 1.0f - lam_init;
      float sl[4];
#pragma unroll
      for (int d0 = 0; d0 < 4; ++d0) sl[d0] = subln[d0 * 32 + r32];
#pragma unroll
      for (int r = 0; r < 16; ++r) {
        const float* pr_ = scrA + launder_i(r * 256 + lane);
        float ss = 0.f;
#pragma unroll
        for (int d0 = 0; d0 < 4; ++d0) { const float dlt = pr_[d0 * 64] - lam * o[d0][r]; o[d0][r] = dlt; ss += dlt * dlt; }
        ss += __shfl_xor(ss, 1); ss += __shfl_xor(ss, 2); ss += __shfl_xor(ss, 4); ss += __shfl_xor(ss, 8); ss += __shfl_xor(ss, 16);
        const float rinv = post / sqrtf(ss * (1.0f / 128.0f) + RMS_EPS);
        const size_t row = roww + launder_i(att::crow(r, hi));
        const bf16_t* gp = H + row * EV_IN + 2304 + h * 128 + r32; bf16_t* op = OG + row * 1024 + h * 128 + r32;
#pragma unroll
        for (int d0 = 0; d0 < 4; ++d0) op[d0 * 32] = att::f2bf(o[d0][r] * rinv * sl[d0] * att::bf2f(gp[d0 * 32]));
      }
    }
  }
#pragma unroll 1
  for (int s_ = 0;; ++s_) {
    int u; if (C.xmode) { const int idx = C.lcu + s_ * C.GX; if (idx >= 128) break; u = C.xcd * 128 + idx; } else { u = C.bid + s_ * C.G; if (u >= 1024) break; }
    const int bh = u >> 4, qb = u & 15, b = bh >> 3, hq = bh & 7, kvh = hq >> 2;
    const size_t rowb = (size_t)b * SEQ;
    att::f32x16 o[2];
    {
      PHASE_IDS();
      bf16_t* H = (bf16_t*)(ws + WS_H);
      const size_t roww = rowb + qb * 256 + wave * 32;
      att::bf16x8 qr[4];
      { const bf16_t* Qw = H + (roww + r32) * EV_IN + 1536 + hq * 64 + hi * 8;
#pragma unroll
        for (int d0 = 0; d0 < 4; ++d0) qr[d0] = *reinterpret_cast<const att::bf16x8*>(Qw + d0 * 16); }
      att::KVSrc kv{H + rowb * EV_IN + 2048 + kvh * 64, EV_IN, nullptr, 0, H + rowb * EV_IN + 2176 + kvh * 64, EV_IN};
#ifndef NO_B
      att::attn_body<64, 64, ATT_ONES_B>(qr, kv, o, (char*)lds, SEQ);
#endif
    }
    {
      PHASE_IDS();
      const bf16_t* H = (const bf16_t*)(ws + WS_H); bf16_t* OG = (bf16_t*)(ws + WS_OG);
      const size_t roww = rowb + qb * 256 + wave * 32;
#pragma unroll
      for (int r = 0; r < 16; ++r) { const size_t row = roww + launder_i(att::crow(r, hi));
        const bf16_t* gp = H + row * EV_IN + 2816 + hq * 64 + r32; bf16_t* op = OG + row * 1024 + 512 + hq * 64 + r32;
#pragma unroll
        for (int d0 = 0; d0 < 2; ++d0) op[d0 * 32] = att::f2bf(o[d0][r] * att::bf2f(gp[d0 * 32])); }
    }
  }
}

__device__ __forceinline__ void phase_o2(const Ctx C, int li) {
  PHASE_IDS();
  const float* qn = P->od_qnorm + li * 256; const float* kvn = P->od_kvnorm + li * 128;
  const float* HF = (const float*)(ws + WS_OG); bf16_t* CQN = (bf16_t*)(ws + WS_CQN); bf16_t* CKVN = (bf16_t*)(ws + WS_CKVN); bf16_t* KRR = (bf16_t*)(ws + WS_KRR);
  const float* tabCc = (const float*)(ws + TAB_C_COS); const float* tabCs = (const float*)(ws + TAB_C_SIN);
  const f32x4 gq = *(const f32x4*)(qn + 4 * lane); const f32x2 gk = *(const f32x2*)(kvn + 2 * lane);
#pragma unroll 2
  for (int t = gw; t < NT_TOK; t += C.NGW) {
    const float* hr = HF + (size_t)t * 512; const int pos = t & (SEQ - 1);
    const f32x4 a = *(const f32x4*)(hr + 4 * lane); const f32x2 c2 = *(const f32x2*)(hr + 256 + 2 * lane);
    const float sa = wave_sum((a[0] * a[0] + a[1] * a[1]) + (a[2] * a[2] + a[3] * a[3])), sc = wave_sum(c2[0] * c2[0] + c2[1] * c2[1]);
    const float ra = 1.0f / sqrtf(sa * (1.0f / 256.0f) + RMS_EPS), rc = 1.0f / sqrtf(sc * (1.0f / 128.0f) + RMS_EPS);
    v2u wq; wq.x = pk2(a[0] * ra * gq[0], a[1] * ra * gq[1]); wq.y = pk2(a[2] * ra * gq[2], a[3] * ra * gq[3]);
    *(v2u*)(CQN + (size_t)t * 256 + 4 * lane) = wq;
    *(unsigned*)(CKVN + (size_t)t * 128 + 2 * lane) = pk2(c2[0] * rc * gk[0], c2[1] * rc * gk[1]);
    if (lane < 16) { const float x1 = hr[384 + lane], x2 = hr[400 + lane], cs = tabCc[pos * 16 + lane], sn = tabCs[pos * 16 + lane];
      KRR[(size_t)t * 32 + lane] = (bf16_t)f2bf_rne(x1 * cs - x2 * sn); KRR[(size_t)t * 32 + 16 + lane] = (bf16_t)f2bf_rne(x2 * cs + x1 * sn); }
  }
}

__device__ __forceinline__ void phase_o4(const Ctx C, unsigned char* lds) {
#pragma unroll 1
  for (int s_ = 0;; ++s_) {
    int u; if (C.xmode) { const int idx = C.lcu + s_ * C.GX; if (idx >= 256) break; u = C.xcd * 256 + idx; } else { u = C.bid + s_ * C.G; if (u >= 2048) break; }
    const int bh = u >> 4, qb = u & 15, b = bh >> 4, h = bh & 15;
    const size_t rowb = (size_t)b * SEQ;
    att::f32x16 o[2];
    {
      PHASE_IDS();
      const bf16_t* QC = (const bf16_t*)(ws + WS_QC); const bf16_t* KVC = (const bf16_t*)(ws + WS_Y); const bf16_t* KRR = (const bf16_t*)(ws + WS_KRR);
      const float* tabCc = (const float*)(ws + TAB_C_COS); const float* tabCs = (const float*)(ws + TAB_C_SIN);
      const size_t roww = rowb + qb * 256 + wave * 32;
      att::bf16x8 qr[6];
      { const bf16_t* Qw = QC + (roww + r32) * 1536 + h * 96 + hi * 8;
#pragma unroll
        for (int d0 = 0; d0 < 6; ++d0) qr[d0] = *reinterpret_cast<const att::bf16x8*>(Qw + d0 * 16);
        const int pos = qb * 256 + wave * 32 + r32;
        float x1[8], x2[8]; unpack8(__builtin_bit_cast(v4u, qr[4]), x1); unpack8(__builtin_bit_cast(v4u, qr[5]), x2);
        float y1[8], y2[8];
#pragma unroll
        for (int k = 0; k < 8; ++k) { const float cs = tabCc[pos * 16 + 8 * hi + k], sn = tabCs[pos * 16 + 8 * hi + k]; y1[k] = x1[k] * cs - x2[k] * sn; y2[k] = x2[k] * cs + x1[k] * sn; }
        qr[4] = __builtin_bit_cast(att::bf16x8, pack8(y1)); qr[5] = __builtin_bit_cast(att::bf16x8, pack8(y2)); }
      att::KVSrc kv{KVC + rowb * 2048 + h * 128, 2048, KRR + rowb * 32, 32, KVC + rowb * 2048 + h * 128 + 64, 2048};
#ifndef NO_C
      att::attn_body<96, 64, ATT_ONES_C>(qr, kv, o, (char*)lds, SEQ);
#endif
    }
    {
      PHASE_IDS();
      const bf16_t* GATE = (const bf16_t*)(ws + WS_GATE); bf16_t* OG = (bf16_t*)(ws + WS_OG);
      const size_t roww = rowb + qb * 256 + wave * 32;
#pragma unroll
      for (int r = 0; r < 16; ++r) { const size_t row = roww + launder_i(att::crow(r, hi));
        const bf16_t* gp = GATE + row * 1024 + h * 64 + r32; bf16_t* op = OG + row * 1024 + h * 64 + r32;
#pragma unroll
        for (int d0 = 0; d0 < 2; ++d0) op[d0 * 32] = att::f2bf(o[d0][r] * att::bf2f(gp[d0 * 32])); }
    }
  }
}

__device__ __forceinline__ void phase_ln(const Ctx C, int layer) {
  PHASE_IDS();
  const int li = layer >> 1;
  const float* lg = ((layer & 1) ? P->od_ln_g : P->ev_ln_g) + li * 1024; const float* lb = ((layer & 1) ? P->od_ln_b : P->ev_ln_b) + li * 1024;
  const float* xin = layer == 0 ? P->x : P->out; float* out = P->out;
  const float* Y = (const float*)(ws + WS_Y); bf16_t* XB = (bf16_t*)(ws + WS_XB);
#pragma unroll 1
  for (int t = gw; t < NT_TOK; t += C.NGW) {
    const f32x4* xr = (const f32x4*)(xin + (size_t)t * 1024) + lane; const f32x4* yr = (const f32x4*)(Y + (size_t)t * 1024) + lane;
    f32x4 v[4]; float s = 0.f;
#pragma unroll
    for (int k = 0; k < 4; ++k) { v[k] = xr[64 * k] * ALPHA + yr[64 * k]; s += (v[k][0] + v[k][1]) + (v[k][2] + v[k][3]); }
    const float mean = wave_sum(s) * (1.0f / 1024.0f); float s2 = 0.f;
#pragma unroll
    for (int k = 0; k < 4; ++k) { v[k] = v[k] - mean; s2 += (v[k][0] * v[k][0] + v[k][1] * v[k][1]) + (v[k][2] * v[k][2] + v[k][3] * v[k][3]); }
    const float rstd = 1.0f / sqrtf(wave_sum(s2) * (1.0f / 1024.0f) + LN_EPS);
    f32x4* orow = (f32x4*)(out + (size_t)t * 1024) + lane; v2u* brow = (v2u*)(XB + (size_t)t * 1024) + lane;
#pragma unroll
    for (int k = 0; k < 4; ++k) { const f32x4 gg = *((const f32x4*)lg + lane + 64 * k), bb = *((const f32x4*)lb + lane + 64 * k);
      const f32x4 r = v[k] * rstd * gg + bb; orow[64 * k] = r; v2u w; w.x = pk2(r[0], r[1]); w.y = pk2(r[2], r[3]); brow[64 * k] = w; }
  }
}

__global__ void __launch_bounds__(512, 2) fwd_kernel(Params p_unused) {
  extern __shared__ __attribute__((aligned(16))) unsigned char lds[];
  cg::grid_group grid = cg::this_grid();
  Ctx C;
  C.G = gridDim.x; C.bid = blockIdx.x;
  C.xmode = ((C.G % 8 == 0) && (C.G >= 8)) ? 1 : 0;
  C.vcu = C.xmode ? (C.bid % 8) * (C.G / 8) + C.bid / 8 : C.bid;
  C.GX = C.xmode ? C.G / 8 : C.G; C.xcd = C.xmode ? C.vcu / C.GX : 0; C.lcu = C.xmode ? C.vcu % C.GX : 0;
  C.NGW = C.G * 8;
  if (threadIdx.x < 8) ((LAS unsigned*)((LAS unsigned char*)lds + 131072))[threadIdx.x] = 0u;
  __syncthreads();
  XcdBarrier bar = xcd_barrier_post((unsigned*)(get_params()->ws + WS_BAR), (volatile LAS unsigned*)((LAS unsigned char*)lds + 131072));
  phase_prologue(C, lds);
  grid.sync();
#pragma unroll 1
  for (int layer = 0; layer < 4; ++layer) {
    const int li = layer >> 1;
    if ((layer & 1) == 0) {
#ifdef REP_GEMM
      for (int rep_ = 0; rep_ < REP_GEMM; ++rep_)
#endif
      phase_gemm_e1(C, lds, li);
      GSYNC();
      phase_e2(C, li); GSYNC();
#ifdef REP_ATT
      for (int rep_ = 0; rep_ < REP_ATT; ++rep_)
#endif
      phase_e3(C, lds, layer);
    } else {
#ifdef REP_GEMM
      for (int rep_ = 0; rep_ < REP_GEMM; ++rep_)
#endif
      phase_gemm_o1(C, lds, li);
      GSYNC();
      phase_o2(C, li); GSYNC();
#ifdef REP_GEMM
      for (int rep_ = 0; rep_ < REP_GEMM; ++rep_)
#endif
      phase_gemm_o3(C, lds, li);
      GSYNC();
#ifdef REP_ATT
      for (int rep_ = 0; rep_ < REP_ATT; ++rep_)
#endif
      phase_o4(C, lds);
    }
    GSYNC();
#ifdef REP_GEMM
    for (int rep_ = 0; rep_ < REP_GEMM; ++rep_)
#endif
    phase_gemm_out(C, lds, layer);
    GSYNC();
    phase_ln(C, layer);
    if (layer < 3) GSYNC();
  }
}

extern "C" void kernel_launch(void* const* d_in, const int* in_sizes, int n_in, void* d_out, int out_size, void* d_ws, size_t ws_size, hipStream_t stream) {
  static int grid_blocks = 0;
  if (grid_blocks == 0) {
    if (n_in != 17 || in_sizes[0] != NT_TOK * DM || out_size != NT_TOK * DM || ws_size < WS_END) {
      fprintf(stderr, "kernel_launch: unexpected shapes: n_in %d in0 %d out %d ws %zu (need >= %zu)\n", n_in, n_in > 0 ? in_sizes[0] : -1, out_size, ws_size, (size_t)WS_END); grid_blocks = -1; return; }
    int dev = 0, cus = 0, per_cu = 0;
    hipGetDevice(&dev); hipDeviceGetAttribute(&cus, hipDeviceAttributeMultiprocessorCount, dev);
    if (hipFuncSetAttribute((const void*)fwd_kernel, hipFuncAttributeMaxDynamicSharedMemorySize, LDS_BYTES) != hipSuccess) { fprintf(stderr, "kernel_launch: hipFuncSetAttribute failed\n"); grid_blocks = -1; return; }
    if (hipOccupancyMaxActiveBlocksPerMultiprocessor(&per_cu, (const void*)fwd_kernel, 512, LDS_BYTES) != hipSuccess || per_cu < 1) { fprintf(stderr, "kernel_launch: occupancy query gave %d\n", per_cu); per_cu = 1; }
    (void)hipGetLastError();
    grid_blocks = cus * 1;
  }
  if (grid_blocks < 0) return;
  Params p{};
  p.x = (const float*)d_in[0]; p.ev_w_in = (const float*)d_in[1]; p.ev_w_out = (const float*)d_in[2]; p.ev_lam = (const float*)d_in[3]; p.ev_subln = (const float*)d_in[4];
  p.ev_qnorm = (const float*)d_in[5]; p.ev_knorm = (const float*)d_in[6]; p.ev_ln_g = (const float*)d_in[7]; p.ev_ln_b = (const float*)d_in[8]; p.od_w_in = (const float*)d_in[9];
  p.od_qnorm = (const float*)d_in[10]; p.od_kvnorm = (const float*)d_in[11]; p.od_w_qb = (const float*)d_in[12]; p.od_w_kvb = (const float*)d_in[13]; p.od_w_out = (const float*)d_in[14];
  p.od_ln_g = (const float*)d_in[15]; p.od_ln_b = (const float*)d_in[16]; p.out = (float*)d_out; p.ws = (unsigned char*)d_ws;
  if (hipMemsetAsync((char*)d_ws + WS_BAR, 0, WS_BAR_BYTES, stream) != hipSuccess) { fprintf(stderr, "kernel_launch: memset of the barrier words failed\n"); return; }
  void* args[] = {&p};
  hipError_t e = hipLaunchCooperativeKernel((const void*)fwd_kernel, dim3(grid_blocks), dim3(512), args, LDS_BYTES, stream);
  if (e != hipSuccess) fprintf(stderr, "kernel_launch: cooperative launch failed: %s (grid %d)\n", hipGetErrorString(e), grid_blocks);
}
```
